# Optimizing an MI355X kernel written in HIP

```python
import math
import jax, jax.numpy as jnp
from jax import lax
import numpy as np

D_MODEL = 2048
BATCH = 2
SEQ = 4096
DEPTH = 1

HEAD_DIM = 128
N_HEADS = D_MODEL // HEAD_DIM
N_DIL_HEADS = N_HEADS // 2
N_FOX_HEADS = N_HEADS - N_DIL_HEADS
DIL_WIDTH = N_DIL_HEADS * HEAD_DIM
FOX_WIDTH = N_FOX_HEADS * HEAD_DIM
DIL_PATTERNS = ((128, 1), (512, 4), (2048, 16))
Q_BLOCK = 128
IN_SPLITS = (DIL_WIDTH, 2 * DIL_WIDTH, 3 * DIL_WIDTH,
             3 * DIL_WIDTH + FOX_WIDTH, 3 * DIL_WIDTH + 2 * FOX_WIDTH,
             3 * DIL_WIDTH + 3 * FOX_WIDTH)
IN_WIDTH = 3 * DIL_WIDTH + 3 * FOX_WIDTH + N_FOX_HEADS
N_EXPERTS = 32
TOP_K = 4
D_FF = D_MODEL
SWIGLU_LIMIT = 7.0
SWIGLU_ALPHA = 1.702
EXPERT_BLOCK = 128
LN_EPS = 1e-5
DEEPNORM_ALPHA = (2.0 * DEPTH) ** 0.25
DEEPNORM_BETA = (8.0 * DEPTH) ** -0.25

kernel_name = 'hybrid_dilated_fox_moe_block'


def layer_norm(x, g, b):
    xf = x.astype(jnp.float32)
    mu = jnp.mean(xf, axis=-1, keepdims=True)
    xc = xf - mu
    var = jnp.mean(xc * xc, axis=-1, keepdims=True)
    return (xc * lax.rsqrt(var + LN_EPS) * g.astype(jnp.float32) + b.astype(jnp.float32)).astype(x.dtype)


def alibi_slopes(n):
    return 2.0 ** (-8.0 * jnp.arange(1, n + 1, dtype=jnp.float32) / n)


def dilated_window_partial(q, k, v, slopes, window, dilation):
    B, S, H, Dh = q.shape
    L = S // dilation
    nb = -(-L // Q_BLOCK)
    Lp = nb * Q_BLOCK
    reach = window // dilation

    def to_sub(t):
        t = t.reshape(B, L, dilation, H, Dh).transpose(0, 2, 3, 1, 4)
        t = jnp.pad(t, ((0, 0), (0, 0), (0, 0), (0, Lp - L), (0, 0)))
        return t.reshape(B, dilation, H, nb, Q_BLOCK, Dh)

    def with_prev(t):
        prev = jnp.pad(t, ((0, 0), (0, 0), (0, 0), (1, 0), (0, 0), (0, 0)))[:, :, :, :-1]
        return jnp.concatenate([prev, t], axis=4)

    qs = to_sub(q)
    kk = with_prev(to_sub(k))
    vv = with_prev(to_sub(v))
    scores = jnp.einsum('brhnqe,brhnke->brhnqk', qs, kk).astype(jnp.float32) / math.sqrt(Dh)
    qi = jnp.arange(Q_BLOCK)[:, None]
    kj = jnp.arange(2 * Q_BLOCK)[None, :]
    delta = qi + Q_BLOCK - kj
    kpos = (jnp.arange(nb)[:, None, None] - 1) * Q_BLOCK + kj[None]
    valid = (delta >= 0) & (delta <= reach) & (kpos >= 0)
    bias = -slopes[:, None, None, None] * (delta * dilation).astype(jnp.float32)
    scores = jnp.where(valid, scores + bias, -jnp.inf)
    m = jnp.max(scores, axis=-1, keepdims=True)
    p = jnp.exp(scores - m)
    l = jnp.sum(p, axis=-1)
    o = jnp.einsum('brhnqk,brhnke->brhnqe', p, vv.astype(jnp.float32))
    o = o.reshape(B, dilation, H, Lp, Dh)[:, :, :, :L].transpose(0, 3, 1, 2, 4).reshape(B, S, H, Dh)
    m = m.reshape(B, dilation, H, Lp)[:, :, :, :L].transpose(0, 3, 1, 2).reshape(B, S, H)
    l = l.reshape(B, dilation, H, Lp)[:, :, :, :L].transpose(0, 3, 1, 2).reshape(B, S, H)
    return o, m, l


def dilated_attention(q, k, v, slopes):
    parts = [dilated_window_partial(q, k, v, slopes, w, d) for (w, d) in DIL_PATTERNS]
    m_max = jnp.max(jnp.stack([p[1] for p in parts]), axis=0)
    num = 0.0
    den = 0.0
    for o_i, m_i, l_i in parts:
        wgt = jnp.exp(m_i - m_max)
        num = num + wgt[..., None] * o_i
        den = den + wgt * l_i
    return num / den[..., None]


def forgetting_attention(q, k, v, log_f):
    B, S, H, Dh = q.shape
    cum = jnp.cumsum(log_f, axis=1).transpose(0, 2, 1)
    kt = k.transpose(0, 2, 1, 3)
    vt = v.transpose(0, 2, 1, 3).astype(jnp.float32)
    nq = S // Q_BLOCK
    qb = q.reshape(B, nq, Q_BLOCK, H, Dh).transpose(1, 0, 3, 2, 4)
    cb = cum.reshape(B, H, nq, Q_BLOCK).transpose(2, 0, 1, 3)
    starts = jnp.arange(nq) * Q_BLOCK
    kpos = jnp.arange(S)
    scale = 1.0 / math.sqrt(Dh)

    def block(args):
        qi, ci, s0 = args
        s = jnp.einsum('bhqe,bhke->bhqk', qi, kt).astype(jnp.float32) * scale
        s = s + ci[..., None] - cum[:, :, None, :]
        qpos = s0 + jnp.arange(Q_BLOCK)
        s = jnp.where(kpos[None, :] <= qpos[:, None], s, -jnp.inf)
        p = jax.nn.softmax(s, axis=-1)
        return jnp.einsum('bhqk,bhke->bhqe', p, vt)

    o = lax.map(block, (qb, cb, starts))
    return o.transpose(1, 0, 3, 2, 4).reshape(B, S, H, Dh)


def moe_ffn(h, w_router, b_router, w_gate_up, b_gate_up, w_down, b_down):
    B, S, D = h.shape
    hf = h.reshape(-1, D)
    T = hf.shape[0]
    logits = (hf @ w_router + b_router).astype(jnp.float32)
    top_val, top_idx = lax.top_k(logits, TOP_K)
    gates = jax.nn.softmax(top_val, axis=-1)
    TK = T * TOP_K
    e_flat = top_idx.reshape(-1)
    g_flat = gates.reshape(-1)
    tok_flat = jnp.arange(TK, dtype=jnp.int32) // TOP_K
    counts = jnp.bincount(e_flat, length=N_EXPERTS)
    padded = (counts + EXPERT_BLOCK - 1) // EXPERT_BLOCK * EXPERT_BLOCK
    pad_end = jnp.cumsum(padded)
    pad_start = pad_end - padded
    grp_start = jnp.cumsum(counts) - counts
    order = jnp.argsort(e_flat)
    e_sorted = e_flat[order]
    dest = pad_start[e_sorted] + jnp.arange(TK) - grp_start[e_sorted]
    nblk = (TK + N_EXPERTS * (EXPERT_BLOCK - 1) + EXPERT_BLOCK - 1) // EXPERT_BLOCK
    row_tok = jnp.zeros((nblk * EXPERT_BLOCK,), jnp.int32).at[dest].set(tok_flat[order])
    row_gate = jnp.zeros((nblk * EXPERT_BLOCK,), jnp.float32).at[dest].set(g_flat[order])
    blk_exp = jnp.minimum(jnp.searchsorted(pad_end, jnp.arange(nblk) * EXPERT_BLOCK, side='right'),
                          N_EXPERTS - 1)

    def expert_block(args):
        tok, gate, e = args
        xb = hf[tok]
        gu = xb @ w_gate_up[e] + b_gate_up[e]
        g, u = jnp.split(gu, 2, axis=-1)
        g = jnp.minimum(g, SWIGLU_LIMIT)
        u = jnp.clip(u, -SWIGLU_LIMIT, SWIGLU_LIMIT)
        act = (u + 1.0) * (g * jax.nn.sigmoid(SWIGLU_ALPHA * g))
        y = act @ w_down[e] + b_down[e]
        return y.astype(jnp.float32) * gate[:, None]

    y = lax.map(expert_block, (row_tok.reshape(nblk, EXPERT_BLOCK),
                               row_gate.reshape(nblk, EXPERT_BLOCK), blk_exp))
    out = jnp.zeros((T, D), jnp.float32).at[row_tok].add(y.reshape(-1, D))
    return out.reshape(B, S, D).astype(h.dtype)


def setup_inputs(seed: int = 0) -> dict:
    key = jax.random.key(seed)
    ks = jax.random.split(key, 17)
    f32 = jnp.float32
    D, E, F = D_MODEL, N_EXPERTS, D_FF
    nrm = lambda k, shape, s: jax.random.normal(k, shape, f32) * s
    return {
        'x': nrm(ks[0], (BATCH, SEQ, D), 1.0),
        'c': nrm(ks[1], (BATCH, D), 1.0),
        'w_ada': nrm(ks[2], (DEPTH, D, 6 * D), D ** -0.5),
        'b_ada': nrm(ks[3], (DEPTH, 6 * D), 0.02),
        'w_in': nrm(ks[4], (DEPTH, D, IN_WIDTH), D ** -0.5),
        'b_forget': 3.0 + nrm(ks[5], (DEPTH, N_FOX_HEADS), 0.1),
        'w_out': nrm(ks[6], (DEPTH, D, D), D ** -0.5 * DEEPNORM_BETA),
        'ln1_g': 1.0 + nrm(ks[7], (DEPTH, D), 0.02),
        'ln1_b': nrm(ks[8], (DEPTH, D), 0.02),
        'w_router': nrm(ks[9], (DEPTH, D, E), D ** -0.5),
        'b_router': nrm(ks[10], (DEPTH, E), 0.01),
        'w_gate_up': nrm(ks[11], (DEPTH, E, D, 2 * F), D ** -0.5),
        'b_gate_up': nrm(ks[12], (DEPTH, E, 2 * F), 0.02),
        'w_down': nrm(ks[13], (DEPTH, E, F, D), F ** -0.5 * DEEPNORM_BETA),
        'b_down': nrm(ks[14], (DEPTH, E, D), 0.02),
        'ln2_g': 1.0 + nrm(ks[15], (DEPTH, D), 0.02),
        'ln2_b': nrm(ks[16], (DEPTH, D), 0.02),
    }


def reference(x, c, w_ada, b_ada, w_in, b_forget, w_out, ln1_g, ln1_b, w_router, b_router,
              w_gate_up, b_gate_up, w_down, b_down, ln2_g, ln2_b):
    B, S, D = x.shape
    slopes = alibi_slopes(N_DIL_HEADS)
    cond = jax.nn.silu(c)
    heads = lambda t: t.reshape(B, S, -1, HEAD_DIM)
    for layer in range(DEPTH):
        mod = cond @ w_ada[layer] + b_ada[layer]
        sh_a, sc_a, g_a, sh_m, sc_m, g_m = jnp.split(mod[:, None, :], 6, axis=-1)
        h = x * (1.0 + sc_a) + sh_a
        proj = h @ w_in[layer]
        qa, ka, va, qf, kf, vf, f_logit = jnp.split(proj, IN_SPLITS, axis=-1)
        o_dil = dilated_attention(heads(qa), heads(ka), heads(va), slopes)
        log_f = jax.nn.log_sigmoid((f_logit + b_forget[layer]).astype(jnp.float32))
        o_fox = forgetting_attention(heads(qf), heads(kf), heads(vf), log_f)
        mixed = jnp.concatenate([o_dil.reshape(B, S, DIL_WIDTH), o_fox.reshape(B, S, FOX_WIDTH)],
                                axis=-1).astype(x.dtype)
        attn = mixed @ w_out[layer]
        x = layer_norm(DEEPNORM_ALPHA * x + g_a * attn, ln1_g[layer], ln1_b[layer])
        h = x * (1.0 + sc_m) + sh_m
        ffn = moe_ffn(h, w_router[layer], b_router[layer], w_gate_up[layer], b_gate_up[layer],
                      w_down[layer], b_down[layer])
        x = layer_norm(DEEPNORM_ALPHA * x + g_m * ffn, ln2_g[layer], ln2_b[layer])
    return x
```

```cpp
#include <hip/hip_runtime.h>
#include <stdint.h>
#include <stdio.h>

typedef unsigned short bf16_t;
typedef short bf16x8 __attribute__((ext_vector_type(8)));
typedef float f32x4 __attribute__((ext_vector_type(4)));
typedef float f32x2 __attribute__((ext_vector_type(2)));
typedef unsigned u32x4 __attribute__((ext_vector_type(4)));
typedef unsigned u32x2 __attribute__((ext_vector_type(2)));
typedef __bf16 bf16x2_t __attribute__((ext_vector_type(2)));

#ifndef N_LAUNCH
#define N_LAUNCH 1
#endif
constexpr int NPHASE = 10;

constexpr int DM = 2048, SEQ = 4096, NTOK = 8192, HD = 128, INW = 6152, QKVW = 6144, NE = 32, FF = 2048;
constexpr float LN_EPS = 1e-5f;
constexpr float ALPHA = 1.189207115002721f;
constexpr float QK_SCALE = 0.08838834764831845f;

constexpr size_t MiB = 1u << 20;
constexpr size_t WS_CTL = 0, CTL_ZERO_BYTES = 1 * MiB;
constexpr size_t WS_MOD = 1 * MiB, WS_LOGF = 2 * MiB, WS_CUM = 3 * MiB, WS_TOPI = 4 * MiB, WS_GATE = 5 * MiB, WS_LIST = 6 * MiB;
constexpr size_t WS_HA = 8 * MiB, WS_QKV = 40 * MiB, WS_MIX = 136 * MiB, WS_Y = 168 * MiB, WS_X1 = 232 * MiB;
constexpr size_t WS_Y2 = 296 * MiB  , WS_PART = 424 * MiB  , WS_LSE = 472 * MiB;
constexpr size_t WS_WINT = 474 * MiB  , WS_WOUTT = 498 * MiB  ;
constexpr size_t WS_WGU8 = 512 * MiB  , WS_WD8 = 768 * MiB  ;
constexpr size_t WS_XS = 896 * MiB  , WS_ACT = 1408 * MiB  , WS_END = 1920 * MiB;
constexpr float SC_ACT = 8.f, SC_WGU = 1024.f, SC_WD = 1792.f;
constexpr size_t WS_XSC = 7 * MiB, WS_HSC = 4 * MiB + 512 * 1024  , WS_MSC = 4 * MiB + 768 * 1024  ;
constexpr size_t WS_MIX8 = 296 * MiB;
constexpr float SC_WIN = 1024.f, SC_WO = 1792.f;
constexpr int CW_BAR = 0;
constexpr int CW_CNT = 4096;
constexpr int CW_ATTQ = 4096 + 64;

constexpr int LDS_BYTES = 147456;
constexpr int LDS_BARW = LDS_BYTES - 16;

#define XB_TMO      128
#define XB_XCNT(j)  (256  + 64 * (j))
#define XB_XSUB(j)  (1280 + 64 * (j))
#define XB_XGEN(j)  (2304 + 64 * (j))
#define XB_TOP      3328
#define XB_TOPGEN   3392
#define XCD_BAR_WORDS 3456
#define XB_SPIN_CAP (1u << 18)
#define LAS __attribute__((address_space(3)))

__device__ __forceinline__ unsigned xb_ld(unsigned* p)              { return __hip_atomic_load(p, __ATOMIC_RELAXED, __HIP_MEMORY_SCOPE_AGENT); }
__device__ __forceinline__ unsigned xb_add(unsigned* p, unsigned v) { return __hip_atomic_fetch_add(p, v, __ATOMIC_RELAXED, __HIP_MEMORY_SCOPE_AGENT); }
__device__ __forceinline__ unsigned xb_xcc_id() { return (unsigned)__builtin_amdgcn_s_getreg((3 << 11) | 20) & 0xFu; }
#define XB_SPIN(cond, bar) do { unsigned _sp = 0; while (cond) { __builtin_amdgcn_s_sleep(1); \
    if ((++_sp & 255u) == 0u) { if (xb_ld(&(bar)[XB_TMO])) break; if (_sp > XB_SPIN_CAP) { atomicAdd(&(bar)[XB_TMO], 1u); break; } } } } while (0)

struct XcdBarrier { unsigned* bar; unsigned x; volatile LAS unsigned* st; };

__device__ __forceinline__ XcdBarrier xcd_barrier_post(unsigned* bar, volatile LAS unsigned* st) {
    XcdBarrier b; b.bar = bar; b.x = xb_xcc_id(); b.st = st;
    if (threadIdx.x == 0) (void)xb_add(&bar[XB_XCNT(b.x)], 1u);
    return b;
}
__device__ __forceinline__ void xcd_barrier_complete(unsigned* bar, unsigned x, unsigned& nloc, unsigned& nx) {
    const unsigned G = gridDim.x * gridDim.y * gridDim.z;
    unsigned sum, cnt, mine, sp = 0u;
    for (;;) {
        sum = 0u; cnt = 0u; mine = 0u;
#pragma unroll
        for (unsigned j = 0; j < 16; ++j) { const unsigned c = xb_ld(&bar[XB_XCNT(j)]); sum += c; cnt += (c > 0u) ? 1u : 0u; mine = (j == x) ? c : mine; }
        if (sum == G) break;
        __builtin_amdgcn_s_sleep(1);
        if ((++sp & 255u) == 0u) { if (xb_ld(&bar[XB_TMO])) break; if (sp > XB_SPIN_CAP) { atomicAdd(&bar[XB_TMO], 1u); break; } }
    }
    nloc = mine > 0u ? mine : 1u; nx = cnt > 0u ? cnt : 1u;
}
__device__ __forceinline__ void xcd_barrier(const XcdBarrier& b) {
    asm volatile("s_waitcnt vmcnt(0)" ::: "memory");
    __syncthreads();
    if (threadIdx.x == 0) {
        unsigned* bar = b.bar;
        __builtin_amdgcn_s_waitcnt(0);
        unsigned nloc = b.st[0], nx = b.st[1];
        if (nloc == 0u) { xcd_barrier_complete(bar, b.x, nloc, nx); b.st[0] = nloc; b.st[1] = nx; }
        const unsigned old = xb_add(&bar[XB_XSUB(b.x)], 1u);
        const unsigned gen = old / nloc;
        if (old + 1u == (gen + 1u) * nloc) {
            __builtin_amdgcn_fence(__ATOMIC_RELEASE, "agent");
            asm volatile("s_waitcnt vmcnt(0)" ::: "memory");
            const unsigned og = xb_add(&bar[XB_TOP], 1u);
            const unsigned tg = og / nx;
            if (og + 1u == (tg + 1u) * nx) xb_add(&bar[XB_TOPGEN], 1u);
            else XB_SPIN(xb_ld(&bar[XB_TOPGEN]) == tg, bar);
            __builtin_amdgcn_fence(__ATOMIC_ACQUIRE, "agent");
            xb_add(&bar[XB_XGEN(b.x)], 1u);
            asm volatile("s_waitcnt vmcnt(0)" ::: "memory");
        } else {
            XB_SPIN(xb_ld(&bar[XB_XGEN(b.x)]) == gen, bar);
            __builtin_amdgcn_fence(__ATOMIC_ACQUIRE, "agent");
            asm volatile("s_waitcnt vmcnt(0)" ::: "memory");
        }
    }
    __syncthreads();
}

__device__ __forceinline__ unsigned cvtpk(float lo, float hi) { f32x2 v = {lo, hi}; bf16x2_t b = __builtin_convertvector(v, bf16x2_t); return __builtin_bit_cast(unsigned, b); }
__device__ __forceinline__ float bf2f(bf16_t v) { return __uint_as_float(((unsigned)v) << 16); }
__device__ __forceinline__ float wave_sum(float v) {
#pragma unroll
    for (int o = 1; o < 64; o <<= 1) v += __shfl_xor(v, o);
    return v;
}
__device__ __forceinline__ float wave_max(float v) {
#pragma unroll
    for (int o = 1; o < 64; o <<= 1) v = fmaxf(v, __shfl_xor(v, o));
    return v;
}

__device__ __forceinline__ unsigned pack_i8x4s(float a, float b, float c, float d, float s) {
    const float MG = 12582912.f, LO = 12582912.f - 127.f, HI = 12582912.f + 127.f;
    const unsigned ta = __float_as_uint(__builtin_amdgcn_fmed3f(__builtin_fmaf(a, s, MG), LO, HI)), tb = __float_as_uint(__builtin_amdgcn_fmed3f(__builtin_fmaf(b, s, MG), LO, HI));
    const unsigned tc = __float_as_uint(__builtin_amdgcn_fmed3f(__builtin_fmaf(c, s, MG), LO, HI)), td = __float_as_uint(__builtin_amdgcn_fmed3f(__builtin_fmaf(d, s, MG), LO, HI));
    const unsigned lo = __builtin_amdgcn_perm(tb, ta, 0x0c0c0400u), hi = __builtin_amdgcn_perm(td, tc, 0x0c0c0400u);
    return __builtin_amdgcn_perm(hi, lo, 0x05040100u);
}
__device__ __forceinline__ unsigned pack_i8x4(float a, float b, float c, float d) { return pack_i8x4s(a, b, c, d, 1.f); }
__device__ __forceinline__ unsigned pack_fp8x4(float a, float b, float c, float d) {
    a = __builtin_amdgcn_fmed3f(a, -448.f, 448.f); b = __builtin_amdgcn_fmed3f(b, -448.f, 448.f); c = __builtin_amdgcn_fmed3f(c, -448.f, 448.f); d = __builtin_amdgcn_fmed3f(d, -448.f, 448.f);
    int p = __builtin_amdgcn_cvt_pk_fp8_f32(a, b, 0, false); p = __builtin_amdgcn_cvt_pk_fp8_f32(c, d, p, true); return (unsigned)p;
}
struct Args { const float* in[17]; float* out; unsigned char* ws; int ph_lo, ph_hi; };

__device__ __forceinline__ void phase_ada(const Args& a, unsigned char* lds, int tid) {
    float* cond = (float*)lds;
    float* red = (float*)(lds + 16384);
    for (int i = tid; i < 4096; i += 512) { const float c = a.in[1][i]; cond[i] = c / (1.f + expf(-c)); }
    __syncthreads();
    const float* w_ada = a.in[2]; const float* b_ada = a.in[3];
    float* mod = (float*)(a.ws + WS_MOD);
    for (int cg = blockIdx.x; cg < 256; cg += gridDim.x) {
        const int col4 = tid % 12, slot = tid / 12;
        if (slot < 42) {
            f32x4 a0 = {0.f, 0.f, 0.f, 0.f}, a1 = {0.f, 0.f, 0.f, 0.f};
            const float* wp = w_ada + cg * 48 + col4 * 4;
#pragma unroll 7
            for (int k = slot; k < 2048; k += 42) {
                const f32x4 w = __builtin_nontemporal_load((const f32x4*)(wp + (size_t)k * 12288));
                a0 += cond[k] * w; a1 += cond[2048 + k] * w;
            }
            float* r = red + (slot * 12 + col4) * 8;
            *(f32x4*)r = a0; *(f32x4*)(r + 4) = a1;
        }
        __syncthreads();
        if (tid < 96) {
            const int b = tid / 48, col = tid % 48; float s = 0.f;
            for (int sl = 0; sl < 42; ++sl) s += red[(sl * 12 + (col >> 2)) * 8 + b * 4 + (col & 3)];
            mod[b * 12288 + cg * 48 + col] = s + b_ada[cg * 48 + col];
        }
        __syncthreads();
    }
}

__device__ __forceinline__ void phase_mod1(const Args& a, unsigned char* lds, int tid, int wid, int lane) {
    float* Wj = (float*)lds;
    const float* w_in = a.in[4];
    for (int k = tid; k < 2048; k += 512) {
        const float* p = w_in + (size_t)k * INW + 6144;
        const f32x4 u = *(const f32x4*)p, v = *(const f32x4*)(p + 4);
        Wj[0 * 2048 + k] = u.x; Wj[1 * 2048 + k] = u.y; Wj[2 * 2048 + k] = u.z; Wj[3 * 2048 + k] = u.w;
        Wj[4 * 2048 + k] = v.x; Wj[5 * 2048 + k] = v.y; Wj[6 * 2048 + k] = v.z; Wj[7 * 2048 + k] = v.w;
    }
    __syncthreads();
    const float* x = a.in[0]; const float* mod = (const float*)(a.ws + WS_MOD); const float* bfo = a.in[5];
    unsigned char* HA = a.ws + WS_HA; float* HSC = (float*)(a.ws + WS_HSC); float* LOGF = (float*)(a.ws + WS_LOGF);
    for (int rg = blockIdx.x * 8 + wid; rg < 2048; rg += gridDim.x * 8) {
        const int row0 = rg * 4, b = row0 >> 12;
        const float* sh = mod + b * 12288; const float* sc = sh + 2048;
        float acc[4][8], am[4];
#pragma unroll
        for (int r = 0; r < 4; ++r) { am[r] = 0.f;
#pragma unroll
            for (int j = 0; j < 8; ++j) acc[r][j] = 0.f; }
#pragma unroll 1
        for (int i = 0; i < 8; ++i) {
            const int k0 = 4 * lane + 256 * i;
            const f32x4 shv = *(const f32x4*)(sh + k0); f32x4 scv = *(const f32x4*)(sc + k0); scv += 1.f;
            f32x4 w[8];
#pragma unroll
            for (int j = 0; j < 8; ++j) w[j] = *(const f32x4*)(Wj + j * 2048 + k0);
#pragma unroll
            for (int r = 0; r < 4; ++r) {
                const f32x4 xv = *(const f32x4*)(x + (size_t)(row0 + r) * DM + k0);
                const f32x4 h = xv * scv + shv;
                am[r] = fmaxf(am[r], fmaxf(fmaxf(fabsf(h.x), fabsf(h.y)), fmaxf(fabsf(h.z), fabsf(h.w))));
#pragma unroll
                for (int j = 0; j < 8; ++j) acc[r][j] += (h.x * w[j].x + h.y * w[j].y) + (h.z * w[j].z + h.w * w[j].w);
            }
        }
        float qs[4];
#pragma unroll
        for (int r = 0; r < 4; ++r) { const float m = fmaxf(wave_max(am[r]), 1e-20f); qs[r] = 127.f / m; if (lane == 0) HSC[row0 + r] = m * (1.f / 127.f); }
#pragma unroll 1
        for (int i = 0; i < 8; ++i) {
            const int k0 = 4 * lane + 256 * i;
            const f32x4 shv = *(const f32x4*)(sh + k0); f32x4 scv = *(const f32x4*)(sc + k0); scv += 1.f;
#pragma unroll
            for (int r = 0; r < 4; ++r) {
                const f32x4 h = *(const f32x4*)(x + (size_t)(row0 + r) * DM + k0) * scv + shv;
                *(unsigned*)(HA + (size_t)(row0 + r) * DM + k0) = pack_i8x4s(h.x, h.y, h.z, h.w, qs[r]);
            }
        }
        float mine = 0.f;
#pragma unroll
        for (int r = 0; r < 4; ++r)
#pragma unroll
            for (int j = 0; j < 8; ++j) { const float s = wave_sum(acc[r][j]); if (lane == r * 8 + j) mine = s; }
        if (lane < 32) {
            const int r = lane >> 3, j = lane & 7;
            const float z = mine + bfo[j];
            LOGF[(size_t)(row0 + r) * 8 + j] = fminf(z, 0.f) - log1pf(expf(-fabsf(z)));
        }
    }
}

__device__ __forceinline__ void phase_cumsum(const Args& a, unsigned char* lds, int tid, int wid, int lane) {
    const float* LOGF = (const float*)(a.ws + WS_LOGF); float* CUM = (float*)(a.ws + WS_CUM);
    float* wtot = (float*)(lds + 131072);
    for (int s = blockIdx.x; s < 16; s += gridDim.x) {
        const int b = s >> 3, h = s & 7;
        float v[8]; float run = 0.f;
#pragma unroll
        for (int i = 0; i < 8; ++i) { const int t = tid * 8 + i; run += LOGF[(size_t)(b * SEQ + t) * 8 + h]; v[i] = run; }
        float tot = run;
#pragma unroll
        for (int o = 1; o < 64; o <<= 1) { const float n = __shfl_up(tot, o); if (lane >= o) tot += n; }
        if (lane == 63) wtot[wid] = tot;
        __syncthreads();
        float base = 0.f;
#pragma unroll
        for (int w = 0; w < 8; ++w) if (w < wid) base += wtot[w];
        const float excl = base + tot - run;
#pragma unroll
        for (int i = 0; i < 8; ++i) CUM[s * SEQ + tid * 8 + i] = (excl + v[i]) * 1.4426950408889634f;
        __syncthreads();
    }
}

__device__ __forceinline__ int swz_off(int row, int chunk) { return row * 128 + (((chunk ^ (row >> 1) ^ ((row >> 4) & 1)) & 7) << 4); }
namespace pg8 {
typedef int i32x4v __attribute__((ext_vector_type(4)));
constexpr int BM = 256, BK = 64, HALF = 128, HTB = HALF * BK * 2;
__device__ __forceinline__ int lds_byte(int r, int c) { const int st = (r >> 4) * 2 + (c >> 5), rr = r & 15, cc = c & 31, ob = rr * 64 + cc * 2; return st * 1024 + (ob ^ (((ob >> 9) & 1) << 5)); }
__device__ __forceinline__ int perm32(int rho) { const int n = rho >> 4, i = rho & 15; return 8 * (i >> 2) + 4 * n + (i & 3); }
__device__ __forceinline__ void stage_rc(int b, int& R, int& C) { const int st = b / 1024, sb = b % 1024, swz = sb ^ (((sb >> 9) & 1) << 5); R = (st >> 1) * 16 + swz / 64; C = (st & 1) * 32 + (swz % 64) / 2; }
struct Unit { int pm, pn, na; };
struct Gemm { const bf16_t* A; const bf16_t* Bt; int K; };
template <bool FP8, class Epi, class Sched, bool ALIGN_EPI>
__device__ __forceinline__ void gemm_phase(LAS unsigned char* lds, const Gemm g, const Sched& S, const Epi& E) {
    const int tid = threadIdx.x, wid = __builtin_amdgcn_readfirstlane(tid >> 6), lane = tid & 63, wr = wid >> 2, wc = wid & 3, fr = lane & 15, fq = lane >> 4;
    const int K = g.K, nt = K / BK;
    unsigned voffA[2], voffB[2];
#pragma unroll
    for (int i = 0; i < 2; ++i) { int R, C; stage_rc(tid * 16 + i * 8192, R, C); const int Rb = (R & ~31) + perm32(R & 31); voffA[i] = (unsigned)(R * K + C) * 2u; voffB[i] = (unsigned)(Rb * 128 + C * 2); }
    const size_t kstep = (size_t)(BK * 2);
    const size_t hstep = (size_t)HALF * K * 2;
    const size_t tstep = 2 * hstep;
    const size_t kstepB = 32768, hstepB = 16384;
    const unsigned ldsw = (unsigned)wid * 1024u;
    const int aoff = lds_byte(wr * 64 + fr, fq * 8), boff = lds_byte(wc * 32 + fr, fq * 8);
#define PG8_SA(b, h) (((b) * 2 + (h)) * HTB)
#define PG8_SB(b, h) ((4 + (b) * 2 + (h)) * HTB)
#define PG8_STAGE(bufoff, gbase, voff) do { _Pragma("unroll") for (int _i = 0; _i < 2; ++_i) \
        __builtin_amdgcn_global_load_lds((const unsigned*)((const char*)(gbase) + (voff)[_i]), (LAS unsigned*)(lds + (bufoff) + ldsw + _i * 8192), 16, 0, 0); } while (0)
#define PG8_STAGE_A(bufoff, gbase, h, nav) do { _Pragma("unroll") for (int _i = 0; _i < 2; ++_i) if (lane == 0 || 2 * (h) + _i < (nav)) \
        __builtin_amdgcn_global_load_lds((const unsigned*)((const char*)(gbase) + voffA[_i]), (LAS unsigned*)(lds + (bufoff) + ldsw + _i * 8192), 16, 0, 0); } while (0)
#define PG8_LDA(dst, b, h) do { _Pragma("unroll") for (int m = 0; m < 4; ++m) _Pragma("unroll") for (int k = 0; k < 2; ++k) dst[m][k] = *(const LAS bf16x8*)(lds + PG8_SA(b, h) + aoff + m * 2048 + k * 1024); } while (0)
#define PG8_LDB(dst, b, h) do { _Pragma("unroll") for (int n = 0; n < 2; ++n) _Pragma("unroll") for (int k = 0; k < 2; ++k) dst[n][k] = *(const LAS bf16x8*)(lds + PG8_SB(b, h) + boff + n * 2048 + k * 1024); } while (0)
#define PG8_MMA(ai, bj, At, Bt) do { __builtin_amdgcn_s_setprio(1); _Pragma("unroll") for (int m = 0; m < 4; ++m) _Pragma("unroll") for (int n = 0; n < 2; ++n) _Pragma("unroll") for (int k = 0; k < 2; ++k) { \
        if (FP8) acc[ai][bj][m][n] = __builtin_bit_cast(f32x4, __builtin_amdgcn_mfma_i32_16x16x64_i8(__builtin_bit_cast(i32x4v, Bt[n][k]), __builtin_bit_cast(i32x4v, At[m][k]), __builtin_bit_cast(i32x4v, acc[ai][bj][m][n]), 0, 0, 0)); \
        else acc[ai][bj][m][n] = __builtin_amdgcn_mfma_f32_16x16x32_bf16(Bt[n][k], At[m][k], acc[ai][bj][m][n], 0, 0, 0); } __builtin_amdgcn_s_setprio(0); } while (0)
#define PG8_WAIT_V(n) asm volatile("s_waitcnt vmcnt(" #n ")" ::: "memory")
#define PG8_WAIT_L(n) asm volatile("s_waitcnt lgkmcnt(" #n ")" ::: "memory")
#define PG8_BAR __builtin_amdgcn_s_barrier()
#define PG8_SCHED __builtin_amdgcn_sched_barrier(0)
    Unit cur, nxt; int ui = 0;
    if (!S.next(0, cur)) return;
    f32x4 acc[2][2][4][2];
#pragma unroll
    for (int a = 0; a < 2; ++a)
#pragma unroll
        for (int b = 0; b < 2; ++b)
#pragma unroll
            for (int m = 0; m < 4; ++m)
#pragma unroll
                for (int n = 0; n < 2; ++n) acc[a][b][m][n] = (f32x4){0.f, 0.f, 0.f, 0.f};
    bf16x8 At[4][2], B0[2][2], B1[2][2];
    const char* cA = (const char*)g.A + (size_t)cur.pm * tstep; const char* cB = (const char*)g.Bt + (size_t)cur.pn * tstep;
    PG8_STAGE(PG8_SB(0, 0), cB, voffB); PG8_STAGE(PG8_SB(0, 1), cB + hstepB, voffB); PG8_STAGE_A(PG8_SA(0, 0), cA, 0, cur.na); PG8_STAGE_A(PG8_SA(0, 1), cA + hstep, 1, cur.na);
    if (wr == 1) PG8_BAR;
    PG8_WAIT_V(2); PG8_BAR;
    PG8_STAGE(PG8_SB(1, 0), cB + kstepB, voffB); PG8_STAGE_A(PG8_SA(1, 0), cA + kstep, 0, cur.na); PG8_STAGE(PG8_SB(1, 1), cB + hstepB + kstepB, voffB);
    PG8_WAIT_V(6); PG8_BAR;
    for (;;) {
        const bool has_next = S.next(ui + 1, nxt);
        const char* nA = has_next ? (const char*)g.A + (size_t)nxt.pm * tstep : cA; const char* nB = has_next ? (const char*)g.Bt + (size_t)nxt.pn * tstep : cB;
        const int cna = cur.na, nna = has_next ? nxt.na : cur.na;
        const bool do0 = cna > wr, do1 = cna > 2 + wr;
        if (!Sched::HAS_LIGHT || (cna == 4 && nna == 4)) {
        for (int t = 0; t < nt; t += 2) {
            const bool last = (t == nt - 2);
            const char* a1 = cA + (size_t)(t + 1) * kstep;
            const char* a2 = last ? nA : cA + (size_t)(t + 2) * kstep; const char* b2 = last ? nB : cB + (size_t)(t + 2) * kstepB;
            const char* a3 = a2 + kstep; const char* b3 = b2 + kstepB;
            PG8_LDB(B0, 0, 0); PG8_LDB(B1, 0, 1); PG8_SCHED; PG8_LDA(At, 0, 0); PG8_STAGE(PG8_SA(1, 1), a1 + hstep, voffA);
            PG8_WAIT_V(8); PG8_WAIT_L(0); PG8_BAR; PG8_MMA(0, 0, At, B0); PG8_MMA(0, 1, At, B1); PG8_BAR; PG8_SCHED;
            PG8_LDA(At, 0, 1); PG8_STAGE(PG8_SB(0, 0), b2, voffB); PG8_STAGE(PG8_SB(0, 1), b2 + hstepB, voffB); PG8_STAGE(PG8_SA(0, 0), a2, voffA);
            PG8_WAIT_V(8); PG8_WAIT_L(0); PG8_BAR; PG8_MMA(1, 0, At, B0); PG8_MMA(1, 1, At, B1); PG8_BAR; PG8_SCHED;
            PG8_LDB(B0, 1, 0); PG8_LDB(B1, 1, 1); PG8_SCHED; PG8_LDA(At, 1, 0); PG8_STAGE(PG8_SA(0, 1), a2 + hstep, voffA);
            PG8_WAIT_V(8); PG8_WAIT_L(0); PG8_BAR; PG8_MMA(0, 0, At, B0); PG8_MMA(0, 1, At, B1); PG8_BAR; PG8_SCHED;
            PG8_LDA(At, 1, 1); PG8_STAGE(PG8_SB(1, 0), b3, voffB); PG8_STAGE(PG8_SB(1, 1), b3 + hstepB, voffB); PG8_STAGE(PG8_SA(1, 0), a3, voffA);
            PG8_WAIT_V(8); PG8_WAIT_L(0); PG8_BAR; PG8_MMA(1, 0, At, B0); PG8_MMA(1, 1, At, B1); PG8_BAR; PG8_SCHED;
        }
        } else {
        for (int t = 0; t < nt; t += 2) {
            const bool last = (t == nt - 2);
            const char* a1 = cA + (size_t)(t + 1) * kstep;
            const char* a2 = last ? nA : cA + (size_t)(t + 2) * kstep; const char* b2 = last ? nB : cB + (size_t)(t + 2) * kstepB;
            const char* a3 = a2 + kstep; const char* b3 = b2 + kstepB;
            const int na2 = last ? nna : cna;
            PG8_LDB(B0, 0, 0); PG8_LDB(B1, 0, 1); PG8_SCHED; PG8_LDA(At, 0, 0); PG8_STAGE_A(PG8_SA(1, 1), a1 + hstep, 1, cna);
            PG8_WAIT_V(8); PG8_WAIT_L(0); PG8_BAR; if (do0) { PG8_MMA(0, 0, At, B0); PG8_MMA(0, 1, At, B1); } PG8_BAR; PG8_SCHED;
            if (do1) PG8_LDA(At, 0, 1); PG8_STAGE(PG8_SB(0, 0), b2, voffB); PG8_STAGE(PG8_SB(0, 1), b2 + hstepB, voffB); PG8_STAGE_A(PG8_SA(0, 0), a2, 0, na2);
            PG8_WAIT_V(8); PG8_WAIT_L(0); PG8_BAR; if (do1) { PG8_MMA(1, 0, At, B0); PG8_MMA(1, 1, At, B1); } PG8_BAR; PG8_SCHED;
            PG8_LDB(B0, 1, 0); PG8_LDB(B1, 1, 1); PG8_SCHED; PG8_LDA(At, 1, 0); PG8_STAGE_A(PG8_SA(0, 1), a2 + hstep, 1, na2);
            PG8_WAIT_V(8); PG8_WAIT_L(0); PG8_BAR; if (do0) { PG8_MMA(0, 0, At, B0); PG8_MMA(0, 1, At, B1); } PG8_BAR; PG8_SCHED;
            if (do1) PG8_LDA(At, 1, 1); PG8_STAGE(PG8_SB(1, 0), b3, voffB); PG8_STAGE(PG8_SB(1, 1), b3 + hstepB, voffB); PG8_STAGE_A(PG8_SA(1, 0), a3, 0, na2);
            PG8_WAIT_V(8); PG8_WAIT_L(0); PG8_BAR; if (do1) { PG8_MMA(1, 0, At, B0); PG8_MMA(1, 1, At, B1); } PG8_BAR; PG8_SCHED;
        }
        }
        if constexpr (ALIGN_EPI) { if (wr == 0) PG8_BAR; }
        { int ln_ = (int)__builtin_amdgcn_mbcnt_hi(~0u, __builtin_amdgcn_mbcnt_lo(~0u, 0u)); asm volatile("" : "+v"(ln_)); const int fr_ = ln_ & 15, fq_ = ln_ >> 4;
          E(acc, cur, wr, wc, fr_, fq_); }
        if (!has_next) break;
#pragma unroll
        for (int a = 0; a < 2; ++a)
#pragma unroll
            for (int b = 0; b < 2; ++b)
#pragma unroll
                for (int m = 0; m < 4; ++m)
#pragma unroll
                    for (int n = 0; n < 2; ++n) acc[a][b][m][n] = (f32x4){0.f, 0.f, 0.f, 0.f};
        cur = nxt; cA = nA; cB = nB; ++ui;
        if constexpr (ALIGN_EPI) { if (wr == 1) PG8_BAR; }
    }
    PG8_WAIT_V(0);
    if constexpr (!ALIGN_EPI) { if (wr == 0) PG8_BAR; }
    PG8_BAR;
#undef PG8_SA
#undef PG8_SB
#undef PG8_STAGE
#undef PG8_STAGE_A
#undef PG8_LDA
#undef PG8_LDB
#undef PG8_MMA
#undef PG8_WAIT_V
#undef PG8_WAIT_L
#undef PG8_BAR
#undef PG8_SCHED
}
}

struct SchedDense {
    static constexpr bool HAS_LIGHT = false;
    int nN, G, vcu, rf;
    __device__ __forceinline__ bool next(int i, pg8::Unit& u) const {
        if (G == 256) { const int rounds = nN >> 3; if (i >= rounds * rf) return false; i = i % rounds;
            const int k = vcu >> 5, j = vcu & 31; u.pm = 8 * (k & 3) + (j & 7); u.pn = 8 * i + 4 * (k >> 2) + (j >> 3); u.na = 4; return true; }
        const int L = i * G + vcu; if (L >= 32 * nN) return false; u.pm = L & 31; u.pn = L >> 5; u.na = 4; return true;
    }
};
struct SchedList {
    static constexpr bool HAS_LIGHT = true;
    const int* ul; int n;
    __device__ __forceinline__ bool next(int i, pg8::Unit& u) const {
        if (i >= n) return false;
        const int v = __builtin_amdgcn_readfirstlane(ul[i]); u.pm = v >> 16; u.pn = v & 0xfff; u.na = (v >> 12) & 7; return true;
    }
};
__device__ __forceinline__ int build_moe_list(int* ul, const int* tb, const int* cn, int NCT, int G, int vcu, int rf, int tid) {
    const int* hb = tb + 160; const int* lb = tb + 200;
    const int H = hb[NE] * NCT, Lt = lb[NE] * NCT;
    const int nh = (H > vcu) ? (H - vcu + G - 1) / G : 0, nl = (Lt > vcu) ? (Lt - vcu + G - 1) / G : 0;
    const int n1 = nh + nl, n = n1 * rf;
    if (tid < n && tid < 64) {
        const int p = tid % n1, kpos = min((vcu * 8) / G, nh), has_l = nl > 0;
        int e = 0, ct, rt, light, idx;
        if (has_l && p == kpos) { light = 1; idx = vcu; }
        else if (p < nh + has_l) { light = 0; idx = vcu + (p - ((has_l && p > kpos) ? 1 : 0)) * G; }
        else { light = 1; idx = vcu + (p - nh) * G; }
        if (light) { for (int q = 1; q < NE; ++q) if (idx >= lb[q] * NCT) e = q; ct = idx - lb[e] * NCT; rt = tb[e + 1] - tb[e] - 1; }
        else { for (int q = 1; q < NE; ++q) if (idx >= hb[q] * NCT) e = q; const int nh_e = hb[e + 1] - hb[e], loc = idx - hb[e] * NCT; ct = loc / nh_e; rt = loc - ct * nh_e; }
        const int rows = cn[e] - rt * 256, na = rows >= 256 ? 4 : (rows + 63) >> 6;
        ul[tid] = ((e * 32 + rt) << 16) | (na << 12) | (e * NCT + ct);
    }
    __syncthreads();
    return n < 64 ? n : 64;
}

__device__ __forceinline__ f32x4 i2f(const f32x4& v) { const pg8::i32x4v i = __builtin_bit_cast(pg8::i32x4v, v); return (f32x4){(float)i[0], (float)i[1], (float)i[2], (float)i[3]}; }
struct EpiQKV {
    bf16_t* O; const float* hsc;
    __device__ __forceinline__ void operator()(const f32x4 (&acc)[2][2][4][2], const pg8::Unit& u, int wr, int wc, int fr, int fq) const {
#pragma unroll
        for (int ai = 0; ai < 2; ++ai)
#pragma unroll
            for (int m = 0; m < 4; ++m) {
                const int row = u.pm * 256 + ai * 128 + wr * 64 + m * 16 + fr;
                const float rs = hsc[row] * (1.f / SC_WIN) * ((u.pn < 4 || (u.pn >= 12 && u.pn < 16)) ? QK_SCALE * 1.4426950408889634f : 1.f);
                bf16_t* rowp = O + (size_t)row * QKVW + u.pn * 256 + wc * 32 + 8 * fq;
#pragma unroll
                for (int bj = 0; bj < 2; ++bj) { const f32x4 v0 = i2f(acc[ai][bj][m][0]) * rs, v1 = i2f(acc[ai][bj][m][1]) * rs; u32x4 o; o.x = cvtpk(v0.x, v0.y); o.y = cvtpk(v0.z, v0.w); o.z = cvtpk(v1.x, v1.y); o.w = cvtpk(v1.z, v1.w); *(u32x4*)(rowp + bj * 128) = o; }
            }
    }
};
struct EpiOut {
    bf16_t* Y; const float* x; const float* mod; const float* msc;
    __device__ __forceinline__ void operator()(const f32x4 (&acc)[2][2][4][2], const pg8::Unit& u, int wr, int wc, int fr, int fq) const {
        const float* ga = mod + ((u.pm * 256) >> 12) * 12288 + 2 * 2048;
#pragma unroll
        for (int ai = 0; ai < 2; ++ai)
#pragma unroll
            for (int m = 0; m < 4; ++m) {
                const int row = u.pm * 256 + ai * 128 + wr * 64 + m * 16 + fr;
                const float rs = msc[row] * (1.f / SC_WO);
#pragma unroll
                for (int bj = 0; bj < 2; ++bj) {
                    const int col = u.pn * 256 + bj * 128 + wc * 32 + 8 * fq;
                    const size_t off = (size_t)row * DM + col;
                    const f32x4 y0 = ALPHA * *(const f32x4*)(x + off) + *(const f32x4*)(ga + col) * (i2f(acc[ai][bj][m][0]) * rs);
                    const f32x4 y1 = ALPHA * *(const f32x4*)(x + off + 4) + *(const f32x4*)(ga + col + 4) * (i2f(acc[ai][bj][m][1]) * rs);
                    u32x4 w; w.x = cvtpk(y0.x, y0.y); w.y = cvtpk(y0.z, y0.w); w.z = cvtpk(y1.x, y1.y); w.w = cvtpk(y1.z, y1.w);
                    *(u32x4*)(Y + off) = w;
                }
            }
    }
};
struct EpiGlu {
    unsigned char* ACT; const float* bgu; const int* cn; const float* xsc;
    __device__ __forceinline__ void operator()(const f32x4 (&acc)[2][2][4][2], const pg8::Unit& u, int wr, int wc, int fr, int fq) const {
        const int e = u.pm >> 5, rt = u.pm & 31, ct = u.pn & 15, nvalid = cn[e] - rt * 256;
        const int col = ct * 128 + wc * 32 + 8 * fq;
        f32x4 bg[2], bu[2];
#pragma unroll
        for (int n = 0; n < 2; ++n) { bg[n] = *(const f32x4*)(bgu + (size_t)e * 2 * FF + col + 4 * n); bu[n] = *(const f32x4*)(bgu + (size_t)e * 2 * FF + FF + col + 4 * n); }
#pragma unroll
        for (int ai = 0; ai < 2; ++ai)
#pragma unroll
            for (int m = 0; m < 4; ++m) {
                const int r = ai * 128 + wr * 64 + m * 16 + fr;
                const float rs = xsc[u.pm * 256 + r] * (1.f / SC_WGU);
                u32x2 w;
#pragma unroll
                for (int n = 0; n < 2; ++n) {
                    const f32x4 g = i2f(acc[ai][0][m][n]) * rs + bg[n], uu = i2f(acc[ai][1][m][n]) * rs + bu[n]; f32x4 o;
#pragma unroll
                    for (int j = 0; j < 4; ++j) {
                        const float gj = fminf(g[j], 7.f), uj = __builtin_amdgcn_fmed3f(uu[j], -7.f, 7.f);
                        o[j] = (uj + 1.f) * (gj * __builtin_amdgcn_rcpf(1.f + __builtin_amdgcn_exp2f(-1.702f * 1.4426950408889634f * gj)));
                    }
                    w[n] = pack_i8x4s(o.x, o.y, o.z, o.w, SC_ACT);
                }
                if (r < nvalid) *(u32x2*)(ACT + (size_t)(u.pm * 256 + r) * FF + col) = w;
            }
    }
};
struct EpiDown {
    unsigned char* Y2; const float* bd; const int* list; const float* gate; const int* cn;
    __device__ __forceinline__ void operator()(const f32x4 (&acc)[2][2][4][2], const pg8::Unit& u, int wr, int wc, int fr, int fq) const {
        const int e = u.pm >> 5, rt = u.pm & 31, ct = u.pn & 7, nvalid = cn[e] - rt * 256;
        const float inv = 1.f / (SC_ACT * SC_WD);
#pragma unroll
        for (int ai = 0; ai < 2; ++ai)
#pragma unroll
            for (int m = 0; m < 4; ++m) {
                const int r = ai * 128 + wr * 64 + m * 16 + fr;
                if (r < nvalid) {
                    const int aid = list[e * NTOK + rt * 256 + r]; const float gt = gate[aid];
#pragma unroll
                    for (int bj = 0; bj < 2; ++bj) {
                        const int col = ct * 256 + bj * 128 + wc * 32 + 8 * fq;
                        const f32x4 v0 = (i2f(acc[ai][bj][m][0]) * inv + *(const f32x4*)(bd + (size_t)e * DM + col)) * gt;
                        const f32x4 v1 = (i2f(acc[ai][bj][m][1]) * inv + *(const f32x4*)(bd + (size_t)e * DM + col + 4)) * gt;
                        u32x2 w; w.x = pack_fp8x4(v0.x, v0.y, v0.z, v0.w); w.y = pack_fp8x4(v1.x, v1.y, v1.z, v1.w);
                        *(u32x2*)(Y2 + (size_t)aid * DM + col) = w;
                    }
                }
            }
    }
};

template <bool FP8, bool NT>
__device__ __forceinline__ void conv_load(f32x4 (&v)[FP8 ? 16 : 8], const float* W, int ldw, int k0, int srccol, int wid) {
    constexpr int RPW = FP8 ? 16 : 8;
#pragma unroll
    for (int j = 0; j < RPW; ++j) { const f32x4* p = (const f32x4*)(W + (size_t)(k0 + wid * RPW + j) * ldw + srccol); v[j] = NT ? __builtin_nontemporal_load(p) : *p; }
}
template <bool FP8>
__device__ __forceinline__ void conv_store(const f32x4 (&v)[FP8 ? 16 : 8], unsigned char* img, unsigned char* dst, size_t hi_off, float scale, int tid, int wid, int lane) {
    constexpr int RPW = FP8 ? 16 : 8;
#pragma unroll
    for (int i = 0; i < 4; ++i) {
        u32x4 o;
        if (FP8) {
            o.x = pack_i8x4s(v[0][i], v[1][i], v[2][i], v[3][i], scale); o.y = pack_i8x4s(v[4][i], v[5][i], v[6][i], v[7][i], scale);
            o.z = pack_i8x4s(v[8 % RPW][i], v[9 % RPW][i], v[10 % RPW][i], v[11 % RPW][i], scale); o.w = pack_i8x4s(v[12 % RPW][i], v[13 % RPW][i], v[14 % RPW][i], v[15 % RPW][i], scale);
        } else { o.x = cvtpk(v[0][i], v[1][i]); o.y = cvtpk(v[2][i], v[3][i]); o.z = cvtpk(v[4][i], v[5][i]); o.w = cvtpk(v[6][i], v[7][i]); }
        *(u32x4*)(img + swz_off(4 * lane + i, wid)) = o;
    }
    __syncthreads();
#pragma unroll
    for (int i = 0; i < 4; ++i) {
        const int n = (tid >> 3) + 64 * i, c = tid & 7;
        __builtin_nontemporal_store(*(const u32x4*)(img + swz_off(n, c)), (u32x4*)(dst + (size_t)(n & 127) * 128 + (size_t)(n >> 7) * hi_off + 16 * c));
    }
    __syncthreads();
}
template <bool FP8, bool NT>
__device__ __forceinline__ void conv_item(unsigned char* img, const float* W, int ldw, int k0, int srccol, unsigned char* dst, size_t hi_off, float scale, int tid, int wid, int lane) {
    f32x4 v[FP8 ? 16 : 8];
    conv_load<FP8, NT>(v, W, ldw, k0, srccol, wid);
    conv_store<FP8>(v, img, dst, hi_off, scale, tid, wid, lane);
}
__device__ __forceinline__ void phase_convert_dense(const Args& a, unsigned char* lds, int tid, int wid, int lane) {
    unsigned char* img = lds + 32768;
    constexpr int I_IN = 16 * 24, I_OUT = 16 * 8;
    for (int it = blockIdx.x; it < I_IN + I_OUT; it += gridDim.x) {
        int r = it;
        if (r < I_IN) { const int kb = r / 24, nb = r % 24;
            conv_item<true, false>(img, a.in[4], INW, kb * 128, nb * 256 + 4 * lane, a.ws + WS_WINT + (size_t)(nb * 16 + kb) * 32768, (size_t)16384, SC_WIN, tid, wid, lane); continue; }
        r -= I_IN;
        { const int kb = r / 8, nb = r % 8;
            conv_item<true, false>(img, a.in[6], DM, kb * 128, nb * 256 + 4 * lane, a.ws + WS_WOUTT + (size_t)(nb * 16 + kb) * 32768, (size_t)16384, SC_WO, tid, wid, lane); }
    }
}
constexpr int N_MOE_CONV = 32 * 16 * 16 + 32 * 16 * 8;
struct MoeItem { const float* W; int ldw, k0, srccol; unsigned char* dst; size_t hi_off; float scale; };
__device__ __forceinline__ MoeItem moe_item(const Args& a, int r, int lane) {
    constexpr int I_GU = 32 * 16 * 16; MoeItem it;
    if (r < I_GU) { const int e = r >> 8, kb = (r >> 4) & 15, cp = (r >> 1) & 7, pass = r & 1;
        it.W = a.in[11] + (size_t)e * DM * 2 * FF; it.ldw = 2 * FF; it.k0 = kb * 128; it.srccol = pass * FF + cp * 256 + 4 * lane;
        it.dst = a.ws + WS_WGU8 + (size_t)((e * 16 + 2 * cp) * 16 + kb) * 32768 + (size_t)pass * 16384; it.hi_off = (size_t)16 * 32768; it.scale = SC_WGU; return it; }
    r -= I_GU;
    { const int e = r >> 7, kb = (r >> 3) & 15, ct = r & 7;
        it.W = a.in[13] + (size_t)e * FF * DM; it.ldw = DM; it.k0 = kb * 128; it.srccol = ct * 256 + 4 * lane;
        it.dst = a.ws + WS_WD8 + (size_t)((e * 8 + ct) * 16 + kb) * 32768; it.hi_off = (size_t)16384; it.scale = SC_WD; return it; }
}
template <int NP>
__device__ __forceinline__ void moe_conv_group(const Args& a, unsigned char* img, int first, int tid, int wid, int lane) {
    f32x4 v0[16], v1[16], v2[16];
    { const MoeItem it = moe_item(a, first, lane); conv_load<true, true>(v0, it.W, it.ldw, it.k0, it.srccol, wid); }
    { const MoeItem it = moe_item(a, first + 1, lane); conv_load<true, true>(v1, it.W, it.ldw, it.k0, it.srccol, wid); }
    { const MoeItem it = moe_item(a, first + 2, lane); conv_load<true, true>(v2, it.W, it.ldw, it.k0, it.srccol, wid); }
#pragma unroll 1
    for (int p = 0; p < NP; ++p) {
        { const MoeItem it = moe_item(a, first + 3 * p, lane); conv_store<true>(v0, img, it.dst, it.hi_off, it.scale, tid, wid, lane); }
        if (p + 1 < NP) { const MoeItem it = moe_item(a, first + 3 * p + 3, lane); conv_load<true, true>(v0, it.W, it.ldw, it.k0, it.srccol, wid); }
        { const MoeItem it = moe_item(a, first + 3 * p + 1, lane); conv_store<true>(v1, img, it.dst, it.hi_off, it.scale, tid, wid, lane); }
        if (p + 1 < NP) { const MoeItem it = moe_item(a, first + 3 * p + 4, lane); conv_load<true, true>(v1, it.W, it.ldw, it.k0, it.srccol, wid); }
        { const MoeItem it = moe_item(a, first + 3 * p + 2, lane); conv_store<true>(v2, img, it.dst, it.hi_off, it.scale, tid, wid, lane); }
        if (p + 1 < NP) { const MoeItem it = moe_item(a, first + 3 * p + 5, lane); conv_load<true, true>(v2, it.W, it.ldw, it.k0, it.srccol, wid); }
    }
}

typedef short v4i16_t __attribute__((ext_vector_type(4)));
constexpr float LOG2E = 1.4426950408889634f;
constexpr float NEGBIG = -1.0e30f;
constexpr int ATT_STAGE = 34816, ATT_NST = 3;
constexpr int ATT_KO = 0, ATT_VO = 16384, ATT_CO = 32768, ATT_Q = ATT_STAGE * ATT_NST;

template <bool FOX>
__device__ __forceinline__ void attn_unit(const Args& a, unsigned char* lds, int b, int h, int dil, int res, int qblk, int pat, int tid, int wid, int lane_in) {
    const bf16_t* QKV = (const bf16_t*)(a.ws + WS_QKV);
    int lane = lane_in; asm volatile("" : "+v"(lane));
    const int fr = lane & 15, fq = lane >> 4;
    const size_t rowb = (size_t)b * SEQ;
    const bf16_t* qsec = QKV + (FOX ? 3072 : 0) + h * HD;
    const char* ksec = (const char*)(QKV + (FOX ? 4096 : 1024) + h * HD);
    const char* vsec = (const char*)(QKV + (FOX ? 5120 : 2048) + h * HD);
    const float* cum = (const float*)(a.ws + WS_CUM) + (b * 8 + h) * SEQ;
    const int i0 = qblk * 256, iq0 = i0 + 32 * wid;
    const int kt_lo = FOX ? 0 : max(0, 4 * qblk - 2), kt_hi = 4 * qblk + 3;
    LAS unsigned char* ldsl = (LAS unsigned char*)lds;
    bf16x8 qf[2][4];
#pragma unroll
    for (int qb = 0; qb < 2; ++qb) {
        const bf16_t* qp = qsec + (rowb + res + (size_t)dil * (iq0 + 16 * qb + fr)) * QKVW + 8 * fq;
#pragma unroll
        for (int s = 0; s < 4; ++s) qf[qb][s] = *(const bf16x8*)(qp + 32 * s);
    }
    float cq[2] = {0.f, 0.f};
    if (FOX) { cq[0] = cum[iq0 + fr]; cq[1] = cum[iq0 + 16 + fr]; }
    const float slope2 = exp2f(-(float)(h + 1)) * (float)dil * LOG2E;
    bool inited[2] = {false, false};
    float mrun[2] = {0.f, 0.f}, lrun[2] = {0.f, 0.f};
    f32x4 ot[2][8];
#pragma unroll
    for (int qb = 0; qb < 2; ++qb)
#pragma unroll
        for (int dt = 0; dt < 8; ++dt) ot[qb][dt] = (f32x4){0.f, 0.f, 0.f, 0.f};
#define ATT_ROW(i) (4 * (wid + 8 * (i)) + (lane >> 4))
#define ATT_KOFF(i) ((unsigned)((size_t)dil * ATT_ROW(i) * QKVW * 2 + (((lane & 15) ^ (ATT_ROW(i) & 15)) << 4)))
#define ATT_VOFF(i) ((unsigned)((size_t)dil * ATT_ROW(i) * QKVW * 2 + (((lane & 15) ^ (2 * (ATT_ROW(i) & 7))) << 4)))
    const size_t tile_bytes = (size_t)dil * 64 * QKVW * 2;
    const char* kbase = ksec + (rowb + res) * (size_t)QKVW * 2;
    const char* vbase = vsec + (rowb + res) * (size_t)QKVW * 2;
#define ATT_STAGE_TILE(st, kt) do { const size_t tb_ = (size_t)(kt) * tile_bytes; _Pragma("unroll") for (int i = 0; i < 2; ++i) { \
        __builtin_amdgcn_global_load_lds((const unsigned*)(kbase + tb_ + ATT_KOFF(i)), (LAS unsigned*)(ldsl + (st) * ATT_STAGE + ATT_KO + (wid + 8 * i) * 1024), 16, 0, 0); \
        __builtin_amdgcn_global_load_lds((const unsigned*)(vbase + tb_ + ATT_VOFF(i)), (LAS unsigned*)(ldsl + (st) * ATT_STAGE + ATT_VO + (wid + 8 * i) * 1024), 16, 0, 0); } \
        if (FOX) __builtin_amdgcn_global_load_lds((const unsigned*)(cum + (kt) * 64 + lane), (LAS unsigned*)(ldsl + (st) * ATT_STAGE + ATT_CO + wid * 256), 4, 0, 0); } while (0)
    const int tq = fr >> 2, tp = fr & 3, r7 = (4 * (fq & 1) + tq) & 7;
    const int trbase = ATT_VO + (4 * fq + tq) * 256 + (tp >> 1) * 16 + (tp & 1) * 8;
    int st_cur = 0;
    ATT_STAGE_TILE(0, kt_lo);
    ATT_STAGE_TILE(1, (kt_lo + 1 <= kt_hi) ? kt_lo + 1 : kt_hi);
    for (int kt = kt_lo; kt <= kt_hi; ++kt) {
        if (FOX) asm volatile("s_waitcnt vmcnt(5) lgkmcnt(0)" ::: "memory"); else asm volatile("s_waitcnt vmcnt(4) lgkmcnt(0)" ::: "memory");
        __builtin_amdgcn_s_barrier();
        asm volatile("" ::: "memory");
        { const int st_n = (st_cur >= 1) ? st_cur - 1 : 2; const int ktn = (kt + 2 <= kt_hi) ? kt + 2 : kt_hi; ATT_STAGE_TILE(st_n, ktn); }
        const int sb = st_cur * ATT_STAGE;
        const int k0 = kt * 64;
        const bool active = FOX ? (k0 <= iq0 + 31) : ((k0 <= iq0 + 31) && (k0 + 63 >= iq0 - 128));
        if (active) {
            const bool boundary = FOX ? (k0 + 63 > iq0) : !((iq0 + 31 - k0 <= 128) && (iq0 - (k0 + 63) >= 0));
            f32x4 st[2][4];
            if (boundary) {
#pragma unroll
                for (int qb = 0; qb < 2; ++qb) {
                    const int iq = iq0 + 16 * qb + fr;
                    const float c0 = FOX ? (cq[qb] - mrun[qb]) : (-slope2 * (float)(iq - k0 - 4 * fq) - mrun[qb]);
#pragma unroll
                    for (int sub = 0; sub < 4; ++sub) {
                        f32x4 ck = {0.f, 0.f, 0.f, 0.f};
                        if (FOX) ck = *(const LAS f32x4*)(ldsl + sb + ATT_CO + wid * 256 + (16 * sub + 4 * fq) * 4);
#pragma unroll
                        for (int j = 0; j < 4; ++j) {
                            const float bv = FOX ? (c0 - ck[j]) : (c0 + slope2 * (float)(16 * sub + j));
                            const int delta = iq - (k0 + 16 * sub + 4 * fq + j);
                            const bool valid = FOX ? (delta >= 0) : ((unsigned)delta <= 128u);
                            st[qb][sub][j] = valid ? bv : NEGBIG;
                        }
                    }
                }
            } else {
#pragma unroll
                for (int qb = 0; qb < 2; ++qb) {
                    const int iq = iq0 + 16 * qb + fr;
                    const float c0 = FOX ? (cq[qb] - mrun[qb]) : (-slope2 * (float)(iq - k0 - 4 * fq) - mrun[qb]);
#pragma unroll
                    for (int sub = 0; sub < 4; ++sub) {
                        f32x4 ck = {0.f, 0.f, 0.f, 0.f};
                        if (FOX) ck = *(const LAS f32x4*)(ldsl + sb + ATT_CO + wid * 256 + (16 * sub + 4 * fq) * 4);
#pragma unroll
                        for (int j = 0; j < 4; ++j) st[qb][sub][j] = FOX ? (c0 - ck[j]) : (c0 + slope2 * (float)(16 * sub + j));
                    }
                }
            }
#pragma unroll
            for (int sub = 0; sub < 4; ++sub) {
#pragma unroll
                for (int s = 0; s < 4; ++s) {
                    const bf16x8 kf = *(const LAS bf16x8*)(ldsl + sb + ATT_KO + (16 * sub + fr) * 256 + (((4 * s + fq) ^ fr) << 4));
                    st[0][sub] = __builtin_amdgcn_mfma_f32_16x16x32_bf16(kf, qf[0][s], st[0][sub], 0, 0, 0);
                    st[1][sub] = __builtin_amdgcn_mfma_f32_16x16x32_bf16(kf, qf[1][s], st[1][sub], 0, 0, 0);
                }
            }
            float mloc[2];
#pragma unroll
            for (int qb = 0; qb < 2; ++qb) {
                float mx = NEGBIG;
#pragma unroll
                for (int sub = 0; sub < 4; ++sub)
#pragma unroll
                    for (int j = 0; j < 4; ++j) mx = fmaxf(mx, st[qb][sub][j]);
                mx = fmaxf(mx, __shfl_xor(mx, 16)); mx = fmaxf(mx, __shfl_xor(mx, 32));
                mloc[qb] = mx;
            }
            const bool need0 = (mloc[0] > -1.0e29f) && (!inited[0] || mloc[0] > 8.f), need1 = (mloc[1] > -1.0e29f) && (!inited[1] || mloc[1] > 8.f);
            if (__any(need0 || need1)) {
#pragma unroll
                for (int qb = 0; qb < 2; ++qb) {
                    const bool nd = (qb == 0) ? need0 : need1;
                    const float shift = nd ? mloc[qb] : 0.f;
                    const float alpha = (nd && inited[qb]) ? __builtin_amdgcn_exp2f(-shift) : 1.f;
                    mrun[qb] += shift; lrun[qb] *= alpha; inited[qb] = inited[qb] || nd;
#pragma unroll
                    for (int dt = 0; dt < 8; ++dt) ot[qb][dt] *= alpha;
#pragma unroll
                    for (int sub = 0; sub < 4; ++sub) st[qb][sub] -= shift;
                }
            }
            bf16x8 pb[2][2];
#pragma unroll
            for (int qb = 0; qb < 2; ++qb) {
                float psum = 0.f;
#pragma unroll
                for (int sub = 0; sub < 4; ++sub)
#pragma unroll
                    for (int j = 0; j < 4; ++j) { const float p = __builtin_amdgcn_exp2f(st[qb][sub][j]); st[qb][sub][j] = p; psum += p; }
                lrun[qb] += psum;
#pragma unroll
                for (int ks = 0; ks < 2; ++ks) {
                    u32x4 w;
                    w.x = cvtpk(st[qb][2 * ks][0], st[qb][2 * ks][1]); w.y = cvtpk(st[qb][2 * ks][2], st[qb][2 * ks][3]);
                    w.z = cvtpk(st[qb][2 * ks + 1][0], st[qb][2 * ks + 1][1]); w.w = cvtpk(st[qb][2 * ks + 1][2], st[qb][2 * ks + 1][3]);
                    pb[qb][ks] = __builtin_bit_cast(bf16x8, w);
                }
            }
#pragma unroll
            for (int dp = 0; dp < 4; ++dp) {
                v4i16_t lo[2][2], hi[2][2];
#pragma unroll
                for (int d2 = 0; d2 < 2; ++d2) {
                    const unsigned dto = (unsigned)(sb + trbase + (((2 * dp + d2) ^ r7) << 5));
#pragma unroll
                    for (int ks = 0; ks < 2; ++ks) {
                        asm volatile("ds_read_b64_tr_b16 %0, %1 offset:%2" : "=&v"(lo[d2][ks]) : "v"(dto), "i"((32 * ks) * 256) : "memory");
                        asm volatile("ds_read_b64_tr_b16 %0, %1 offset:%2" : "=&v"(hi[d2][ks]) : "v"(dto), "i"((32 * ks + 16) * 256) : "memory");
                    }
                }
                asm volatile("s_waitcnt lgkmcnt(0)" ::: "memory");
                __builtin_amdgcn_sched_barrier(0);
#pragma unroll
                for (int d2 = 0; d2 < 2; ++d2)
#pragma unroll
                    for (int ks = 0; ks < 2; ++ks) {
                        const bf16x8 va = {lo[d2][ks][0], lo[d2][ks][1], lo[d2][ks][2], lo[d2][ks][3], hi[d2][ks][0], hi[d2][ks][1], hi[d2][ks][2], hi[d2][ks][3]};
                        ot[0][2 * dp + d2] = __builtin_amdgcn_mfma_f32_16x16x32_bf16(va, pb[0][ks], ot[0][2 * dp + d2], 0, 0, 0);
                        ot[1][2 * dp + d2] = __builtin_amdgcn_mfma_f32_16x16x32_bf16(va, pb[1][ks], ot[1][2 * dp + d2], 0, 0, 0);
                    }
            }
        }
        st_cur = (st_cur == 2) ? 0 : st_cur + 1;
    }
#undef ATT_STAGE_TILE
#undef ATT_ROW
#undef ATT_KOFF
#undef ATT_VOFF
    asm volatile("s_waitcnt vmcnt(0) lgkmcnt(0)" ::: "memory");
    __builtin_amdgcn_s_barrier();
#pragma unroll
    for (int qb = 0; qb < 2; ++qb) {
        float lt = lrun[qb]; lt += __shfl_xor(lt, 16); lt += __shfl_xor(lt, 32);
        const float inv = 1.f / lt;
        const size_t row = rowb + res + (size_t)dil * (iq0 + 16 * qb + fr);
        bf16_t* op = FOX ? ((bf16_t*)(a.ws + WS_MIX) + row * DM + 1024 + h * HD + 4 * fq)
                         : ((bf16_t*)(a.ws + WS_PART) + ((size_t)pat * NTOK + row) * 1024 + h * HD + 4 * fq);
#pragma unroll
        for (int dt = 0; dt < 8; ++dt) {
            const f32x4 v = ot[qb][dt] * inv; u32x2 w; w.x = cvtpk(v.x, v.y); w.y = cvtpk(v.z, v.w);
            *(u32x2*)(op + 16 * dt) = w;
        }
        if (!FOX && fq == 0) ((float*)(a.ws + WS_LSE))[((size_t)pat * NTOK + row) * 8 + h] = mrun[qb] + __builtin_amdgcn_logf(lt);
    }
}

__device__ __forceinline__ void phase_attn(const Args& a, unsigned char* lds, int tid, int wid, int lane, int rep) {
    unsigned* QA = (unsigned*)(a.ws + WS_CTL) + CW_ATTQ + 64 * rep;
    unsigned* QC = (unsigned*)(a.ws + WS_CTL) + CW_ATTQ + 128 + 64 * rep;
    constexpr int NCG = N_MOE_CONV / 6;
    volatile int* qw = (volatile int*)(lds + ATT_Q);
    const bool pref_conv = (blockIdx.x % 5) < 3;
    bool a_done = false, c_done = (rep != 0);
    for (;;) {
        __syncthreads();
        if (tid == 0) {
            int kind = -1, idx = 0;
#pragma unroll
            for (int pass = 0; pass < 2; ++pass) {
                const bool try_conv = (pass == 0) ? pref_conv : !pref_conv;
                if (kind < 0) {
                    if (try_conv) { if (!c_done) { idx = (int)__hip_atomic_fetch_add(QC, 1u, __ATOMIC_RELAXED, __HIP_MEMORY_SCOPE_AGENT); if (idx < NCG) kind = 1; else c_done = true; } }
                    else { if (!a_done) { idx = (int)__hip_atomic_fetch_add(QA, 1u, __ATOMIC_RELAXED, __HIP_MEMORY_SCOPE_AGENT); if (idx < 1024) kind = 0; else a_done = true; } }
                }
            }
            qw[0] = kind; qw[1] = idx;
        }
        __syncthreads();
        const int kind = __builtin_amdgcn_readfirstlane(qw[0]), u = __builtin_amdgcn_readfirstlane(qw[1]);
        if (kind < 0) break;
        if (kind == 1) {
            moe_conv_group<2>(a, lds + 65536, u * 6, tid, wid, lane);
            continue;
        }
        if (u < 256) { const int bh = u & 15; attn_unit<true>(a, lds, bh >> 3, bh & 7, 1, 0, 15 - (u >> 4), 0, tid, wid, lane); }
        else {
            const int up = u - 256, pat = up >> 8, v = up & 255, bh = v & 15, sub = v >> 4;
            const int dil = (pat == 0) ? 1 : (pat == 1 ? 4 : 16);
            const int res = (pat == 0) ? 0 : (pat == 1 ? (sub & 3) : sub);
            const int qblk = (pat == 0) ? sub : (pat == 1 ? (sub >> 2) : 0);
            attn_unit<false>(a, lds, bh >> 3, bh & 7, dil, res, qblk, pat, tid, wid, lane);
        }
    }
}

__device__ __forceinline__ void phase_combine(const Args& a, int wid, int lane) {
    const bf16_t* PART = (const bf16_t*)(a.ws + WS_PART); const float* LSE = (const float*)(a.ws + WS_LSE); const bf16_t* MIX = (const bf16_t*)(a.ws + WS_MIX);
    unsigned char* MIX8 = a.ws + WS_MIX8; float* MSC = (float*)(a.ws + WS_MSC);
    const int h = lane >> 3, c = (lane & 7) * 16;
    for (int row = blockIdx.x * 8 + wid; row < NTOK; row += gridDim.x * 8) {
        float l0 = LSE[(size_t)row * 8 + h], l1 = LSE[((size_t)NTOK + row) * 8 + h], l2 = LSE[((size_t)2 * NTOK + row) * 8 + h];
        const float mx = fmaxf(l0, fmaxf(l1, l2));
        float w0 = __builtin_amdgcn_exp2f(l0 - mx), w1 = __builtin_amdgcn_exp2f(l1 - mx), w2 = __builtin_amdgcn_exp2f(l2 - mx);
        const float inv = 1.f / (w0 + w1 + w2); w0 *= inv; w1 *= inv; w2 *= inv;
        float d[16], f[16]; float am = 0.f;
#pragma unroll
        for (int half = 0; half < 2; ++half) {
            const size_t off = (size_t)row * 1024 + h * HD + c + half * 8;
            const u32x4 p0 = *(const u32x4*)(PART + off), p1 = *(const u32x4*)(PART + (size_t)NTOK * 1024 + off), p2 = *(const u32x4*)(PART + (size_t)2 * NTOK * 1024 + off);
            const u32x4 fx = *(const u32x4*)(MIX + (size_t)row * DM + 1024 + 16 * lane + half * 8);
#pragma unroll
            for (int q = 0; q < 4; ++q) {
                d[half * 8 + 2 * q] = w0 * __uint_as_float(p0[q] << 16) + w1 * __uint_as_float(p1[q] << 16) + w2 * __uint_as_float(p2[q] << 16);
                d[half * 8 + 2 * q + 1] = w0 * __uint_as_float(p0[q] & 0xffff0000u) + w1 * __uint_as_float(p1[q] & 0xffff0000u) + w2 * __uint_as_float(p2[q] & 0xffff0000u);
                f[half * 8 + 2 * q] = __uint_as_float(fx[q] << 16); f[half * 8 + 2 * q + 1] = __uint_as_float(fx[q] & 0xffff0000u);
            }
        }
#pragma unroll
        for (int q = 0; q < 16; ++q) am = fmaxf(am, fmaxf(fabsf(d[q]), fabsf(f[q])));
        am = fmaxf(wave_max(am), 1e-20f);
        const float qs = 127.f / am; if (lane == 0) MSC[row] = am * (1.f / 127.f);
        u32x4 od, of;
#pragma unroll
        for (int q = 0; q < 4; ++q) { od[q] = pack_i8x4s(d[4 * q], d[4 * q + 1], d[4 * q + 2], d[4 * q + 3], qs); of[q] = pack_i8x4s(f[4 * q], f[4 * q + 1], f[4 * q + 2], f[4 * q + 3], qs); }
        *(u32x4*)(MIX8 + (size_t)row * DM + h * HD + c) = od;
        *(u32x4*)(MIX8 + (size_t)row * DM + 1024 + 16 * lane) = of;
    }
}

__device__ __forceinline__ void phase_ln1_router(const Args& a, unsigned char* lds, int tid, int wid, int lane) {
    constexpr int HP = 2050;
    float* hsa = (float*)lds;
    float* hs = hsa + (wid * 2) * HP;
    float* red = (float*)lds;
    float* lg = (float*)(lds + 132096);
    int* hist = (int*)(lds + 132096 + 2048);
    int* base = hist + 32;
    const bf16_t* Y = (const bf16_t*)(a.ws + WS_Y); bf16_t* X1 = (bf16_t*)(a.ws + WS_X1); unsigned char* XS = a.ws + WS_XS;
    const float* mod = (const float*)(a.ws + WS_MOD);
    const float* g1 = a.in[7]; const float* b1 = a.in[8]; const float* wrt = a.in[9]; const float* brt = a.in[10];
    int* TOPI = (int*)(a.ws + WS_TOPI); float* GATE = (float*)(a.ws + WS_GATE); int* LIST = (int*)(a.ws + WS_LIST);
    unsigned* CNT = (unsigned*)(a.ws + WS_CTL) + CW_CNT;
    for (int rb = blockIdx.x; rb < 512; rb += gridDim.x) {
        const int row0 = rb * 16 + wid * 2, b = row0 >> 12;
        const float* shm = mod + b * 12288 + 3 * 2048; const float* scm = mod + b * 12288 + 4 * 2048;
        unsigned hq[2][8]; float hsc[2];
#pragma unroll
        for (int r = 0; r < 2; ++r) {
            f32x4 v[8]; float s = 0.f;
#pragma unroll
            for (int i = 0; i < 8; ++i) { const u32x2 yw = *(const u32x2*)(Y + (size_t)(row0 + r) * DM + 4 * lane + 256 * i);
                v[i] = (f32x4){__uint_as_float(yw.x << 16), __uint_as_float(yw.x & 0xffff0000u), __uint_as_float(yw.y << 16), __uint_as_float(yw.y & 0xffff0000u)}; s += (v[i].x + v[i].y) + (v[i].z + v[i].w); }
            const float mean = wave_sum(s) * (1.f / DM); float q = 0.f;
#pragma unroll
            for (int i = 0; i < 8; ++i) { v[i] -= mean; q += (v[i].x * v[i].x + v[i].y * v[i].y) + (v[i].z * v[i].z + v[i].w * v[i].w); }
            const float rstd = 1.f / sqrtf(wave_sum(q) * (1.f / DM) + LN_EPS);
#pragma unroll
            for (int i = 0; i < 8; ++i) {
                const int k0 = 4 * lane + 256 * i;
                const f32x4 x1 = v[i] * rstd * *(const f32x4*)(g1 + k0) + *(const f32x4*)(b1 + k0);
                { u32x2 xw; xw.x = cvtpk(x1.x, x1.y); xw.y = cvtpk(x1.z, x1.w); *(u32x2*)(X1 + (size_t)(row0 + r) * DM + k0) = xw; }
                const f32x4 h2 = x1 * (*(const f32x4*)(scm + k0) + 1.f) + *(const f32x4*)(shm + k0);
                v[i] = h2;
                *(f32x2*)(hs + r * HP + k0) = (f32x2){h2.x, h2.y}; *(f32x2*)(hs + r * HP + k0 + 2) = (f32x2){h2.z, h2.w};
            }
            float am = 0.f;
#pragma unroll
            for (int i = 0; i < 8; ++i) am = fmaxf(am, fmaxf(fmaxf(fabsf(v[i].x), fabsf(v[i].y)), fmaxf(fabsf(v[i].z), fabsf(v[i].w))));
            am = fmaxf(wave_max(am), 1e-20f);
            const float qs = 127.f / am; hsc[r] = am * (1.f / 127.f);
#pragma unroll
            for (int i = 0; i < 8; ++i) hq[r][i] = pack_i8x4s(v[i].x, v[i].y, v[i].z, v[i].w, qs);
        }
        __syncthreads();
        {
            f32x4 c0 = {0.f, 0.f, 0.f, 0.f}, c1 = {0.f, 0.f, 0.f, 0.f};
            const int fr = lane & 15, fq = lane >> 4;
            const float* ap = hsa + fr * HP + 256 * wid + fq;
            const float* bp = wrt + (size_t)(256 * wid + fq) * NE + 2 * fr;
#pragma unroll 16
            for (int st = 0; st < 64; ++st) {
                const float av = ap[4 * st];
                const f32x2 bb = *(const f32x2*)(bp + (size_t)(4 * st) * NE);
                c0 = __builtin_amdgcn_mfma_f32_16x16x4f32(av, bb.x, c0, 0, 0, 0);
                c1 = __builtin_amdgcn_mfma_f32_16x16x4f32(av, bb.y, c1, 0, 0, 0);
            }
            __syncthreads();
#pragma unroll
            for (int j = 0; j < 4; ++j) *(f32x2*)(red + (wid * 16 + 4 * fq + j) * 32 + 2 * fr) = (f32x2){c0[j], c1[j]};
            __syncthreads();
            { const int tk = tid >> 5, e = tid & 31; float sum = brt[e];
#pragma unroll
              for (int w = 0; w < 8; ++w) sum += red[(w * 16 + tk) * 32 + e];
              lg[tk * 32 + e] = sum; }
        }
        if (tid < 32) hist[tid] = 0;
        __syncthreads();
        int esel[4], rank[4];
#pragma unroll
        for (int s = 0; s < 4; ++s) { esel[s] = 0; rank[s] = 0; }
        const int tok = row0 + lane;
        float tv[4];
        {
            float lv = lg[(wid * 2 + (lane >> 5)) * 32 + (lane & 31)];
#pragma unroll
            for (int s = 0; s < 4; ++s) {
                float best = lv;
#pragma unroll
                for (int o = 1; o < 32; o <<= 1) best = fmaxf(best, __shfl_xor(best, o));
                const unsigned long long bm = __ballot(lv == best);
                const int bi = __builtin_ctz((unsigned)(bm >> (lane & 32)));
                if ((lane & 31) == bi) lv = -3.0e38f;
                tv[s] = __shfl(best, (lane & 1) * 32); esel[s] = __shfl(bi, (lane & 1) * 32);
            }
        }
        if (lane < 2) {
            const float e0 = 1.f, e1 = expf(tv[1] - tv[0]), e2 = expf(tv[2] - tv[0]), e3 = expf(tv[3] - tv[0]);
            const float inv = 1.f / (e0 + e1 + e2 + e3);
            GATE[tok * 4 + 0] = e0 * inv; GATE[tok * 4 + 1] = e1 * inv; GATE[tok * 4 + 2] = e2 * inv; GATE[tok * 4 + 3] = e3 * inv;
#pragma unroll
            for (int s = 0; s < 4; ++s) { TOPI[tok * 4 + s] = esel[s]; rank[s] = atomicAdd(&hist[esel[s]], 1); }
        }
        __syncthreads();
        if (tid < 32) base[tid] = (int)__hip_atomic_fetch_add(&CNT[tid], (unsigned)hist[tid], __ATOMIC_RELAXED, __HIP_MEMORY_SCOPE_AGENT);
        __syncthreads();
        int pos[4];
#pragma unroll
        for (int s = 0; s < 4; ++s) pos[s] = 0;
        if (lane < 2) {
#pragma unroll
            for (int s = 0; s < 4; ++s) { pos[s] = base[esel[s]] + rank[s]; LIST[esel[s] * NTOK + pos[s]] = tok * 4 + s; }
        }
#pragma unroll
        for (int r = 0; r < 2; ++r)
#pragma unroll
            for (int s = 0; s < 4; ++s) {
                const int e = __shfl(esel[s], r), p = __shfl(pos[s], r);
                unsigned char* dstp = XS + ((size_t)e * NTOK + p) * DM + 4 * lane;
#pragma unroll
                for (int i = 0; i < 8; ++i) *(unsigned*)(dstp + 256 * i) = hq[r][i];
                if (lane == 0) ((float*)(a.ws + WS_XSC))[(size_t)e * NTOK + p] = hsc[r];
            }
        __syncthreads();
    }
}

__device__ __forceinline__ void phase_final(const Args& a, int wid, int lane) {
    const bf16_t* X1 = (const bf16_t*)(a.ws + WS_X1); const unsigned char* Y2 = a.ws + WS_Y2; const float* mod = (const float*)(a.ws + WS_MOD);
    const float* g2 = a.in[15]; const float* b2 = a.in[16];
    for (int row = blockIdx.x * 8 + wid; row < NTOK; row += gridDim.x * 8) {
        const int b = row >> 12; const float* gm = mod + b * 12288 + 5 * 2048;
        f32x4 v[8]; float s = 0.f;
#pragma unroll
        for (int i = 0; i < 8; ++i) {
            const int k0 = 4 * lane + 256 * i;
            f32x4 f = {0.f, 0.f, 0.f, 0.f};
#pragma unroll
            for (int sl = 0; sl < 4; ++sl) {
                const int w = (int)__builtin_nontemporal_load((const unsigned*)(Y2 + (size_t)(row * 4 + sl) * DM + k0));
                const f32x2 lo = __builtin_amdgcn_cvt_pk_f32_fp8(w, false), hi = __builtin_amdgcn_cvt_pk_f32_fp8(w, true);
                f.x += lo[0]; f.y += lo[1]; f.z += hi[0]; f.w += hi[1];
            }
            const u32x2 xw = *(const u32x2*)(X1 + (size_t)row * DM + k0);
            const f32x4 x1v = {__uint_as_float(xw.x << 16), __uint_as_float(xw.x & 0xffff0000u), __uint_as_float(xw.y << 16), __uint_as_float(xw.y & 0xffff0000u)};
            v[i] = ALPHA * x1v + *(const f32x4*)(gm + k0) * f;
            s += (v[i].x + v[i].y) + (v[i].z + v[i].w);
        }
        const float mean = wave_sum(s) * (1.f / DM); float q = 0.f;
#pragma unroll
        for (int i = 0; i < 8; ++i) { v[i] -= mean; q += (v[i].x * v[i].x + v[i].y * v[i].y) + (v[i].z * v[i].z + v[i].w * v[i].w); }
        const float rstd = 1.f / sqrtf(wave_sum(q) * (1.f / DM) + LN_EPS);
#pragma unroll
        for (int i = 0; i < 8; ++i) {
            const int k0 = 4 * lane + 256 * i;
            __builtin_nontemporal_store(v[i] * rstd * *(const f32x4*)(g2 + k0) + *(const f32x4*)(b2 + k0), (f32x4*)(a.out + (size_t)row * DM + k0));
        }
    }
}

__global__ void __launch_bounds__(512, 2) fwd_kernel(Args a) {
    extern __shared__ __attribute__((aligned(16))) unsigned char lds[];
    const int tid = threadIdx.x, lane = tid & 63, wid = __builtin_amdgcn_readfirstlane(tid >> 6);
    const int G = gridDim.x, bx = blockIdx.x;
    const int vcu = (G % 8 == 0) ? (bx % 8) * (G / 8) + bx / 8 : bx;
    if (tid < 4) ((unsigned*)(lds + LDS_BARW))[tid] = 0u;
    __syncthreads();
    unsigned* ctl = (unsigned*)(a.ws + WS_CTL);
    XcdBarrier bar; bar.bar = ctl + CW_BAR; bar.x = 0; bar.st = nullptr;
    if (N_LAUNCH == 1) bar = xcd_barrier_post(ctl + CW_BAR, (volatile LAS unsigned*)(lds + LDS_BARW));
    const int lo = a.ph_lo, hi = a.ph_hi;
#ifndef PHASE_MASK
#define PHASE_MASK 0x3ff
#endif
#define IN(k) (((PHASE_MASK >> (k)) & 1) && lo <= (k) && (k) < hi)
#define SEAM(k) do { if (IN(k) && IN((k) + 1)) xcd_barrier(bar); } while (0)
#ifndef REPEAT_MASK
#define REPEAT_MASK 0
#endif
#define RF(k) ((((REPEAT_MASK) >> (k)) & 1) + 1)
#define REP(k) _Pragma("unroll 1") for (int rep_ = 0; rep_ < (((REPEAT_MASK) >> (k)) & 1) + 1; ++rep_)

    LAS unsigned char* ldsl = (LAS unsigned char*)lds;
    if (IN(0)) { phase_ada(a, lds, tid); for (int rp = 0; rp < RF(0); ++rp) phase_convert_dense(a, lds, tid, wid, lane); if (RF(10) > 1) phase_ada(a, lds, tid); } SEAM(0);
    if (IN(1)) { for (int rp = 0; rp < RF(1); ++rp) phase_mod1(a, lds, tid, wid, lane); } SEAM(1);
    if (IN(2)) {
        phase_cumsum(a, lds, tid, wid, lane);
        __syncthreads();
        const pg8::Gemm g{(const bf16_t*)(a.ws + WS_HA), (const bf16_t*)(a.ws + WS_WINT), DM / 2};
        const SchedDense S{24, G, vcu, RF(2)}; const EpiQKV E{(bf16_t*)(a.ws + WS_QKV), (const float*)(a.ws + WS_HSC)};
        pg8::gemm_phase<true, EpiQKV, SchedDense, true>(ldsl, g, S, E);
        __syncthreads();
    } SEAM(2);
    if (IN(3)) { phase_attn(a, lds, tid, wid, lane, 0); if (RF(3) > 1) { xcd_barrier(bar); phase_attn(a, lds, tid, wid, lane, 1); } } SEAM(3);
    if (IN(4)) { for (int rp = 0; rp < RF(4); ++rp) phase_combine(a, wid, lane); } SEAM(4);
    if (IN(5)) {
        const pg8::Gemm g{(const bf16_t*)(a.ws + WS_MIX8), (const bf16_t*)(a.ws + WS_WOUTT), DM / 2};
        const SchedDense S{8, G, vcu, RF(5)}; const EpiOut E{(bf16_t*)(a.ws + WS_Y), a.in[0], (const float*)(a.ws + WS_MOD), (const float*)(a.ws + WS_MSC)};
        pg8::gemm_phase<true, EpiOut, SchedDense, false>(ldsl, g, S, E);
        __syncthreads();
    } SEAM(5);
    if (IN(6)) { phase_ln1_router(a, lds, tid, wid, lane); } SEAM(6);
    if (IN(7) || IN(8)) {
        int* tb = (int*)(lds + 140000);
        int* cn = tb + 40;
        const unsigned* CNT = ctl + CW_CNT;
        __syncthreads();
        if (tid == 0) { int acc = 0, ah = 0, al = 0; for (int e = 0; e < NE; ++e) { const int c = (int)CNT[e], nt_e = (c + 255) >> 8, lt = (nt_e > 0 && c - (nt_e - 1) * 256 <= 128) ? 1 : 0;
                cn[e] = c; tb[e] = acc; tb[160 + e] = ah; tb[200 + e] = al; acc += nt_e; ah += nt_e - lt; al += lt; } tb[NE] = acc; tb[160 + NE] = ah; tb[200 + NE] = al; }
        __syncthreads();
        if (IN(7)) {
            const pg8::Gemm g{(const bf16_t*)(a.ws + WS_XS), (const bf16_t*)(a.ws + WS_WGU8), DM / 2};
            const int nu = build_moe_list(tb + 80, tb, cn, 16, G, vcu, RF(7), tid);
            const SchedList S{tb + 80, nu}; const EpiGlu E{a.ws + WS_ACT, a.in[12], cn, (const float*)(a.ws + WS_XSC)};
            pg8::gemm_phase<true, EpiGlu, SchedList, true>(ldsl, g, S, E);
            __syncthreads();
        }
        SEAM(7);
        if (IN(8)) {
            const pg8::Gemm g{(const bf16_t*)(a.ws + WS_ACT), (const bf16_t*)(a.ws + WS_WD8), FF / 2};
            const int nu = build_moe_list(tb + 80, tb, cn, 8, G, vcu, RF(8), tid);
            const SchedList S{tb + 80, nu}; const EpiDown E{a.ws + WS_Y2, a.in[14], (const int*)(a.ws + WS_LIST), (const float*)(a.ws + WS_GATE), cn};
            pg8::gemm_phase<true, EpiDown, SchedList, true>(ldsl, g, S, E);
            __syncthreads();
        }
    }
    SEAM(8);
    if (IN(9)) { for (int rp = 0; rp < RF(9); ++rp) phase_final(a, wid, lane); }
#undef IN
#undef SEAM
}

extern "C" void kernel_launch(void* const* d_in, const int* in_sizes, int n_in, void* d_out, int out_size, void* d_ws, size_t ws_size, hipStream_t stream) {
    static int grid = 0;
    if (grid == 0) {
        int dev = 0, cus = 0;
        if (n_in != 17 || ws_size < WS_END) { fprintf(stderr, "kernel_launch: unexpected n_in %d / ws %zu\n", n_in, ws_size); grid = -1; return; }
        if (hipGetDevice(&dev) != hipSuccess || hipDeviceGetAttribute(&cus, hipDeviceAttributeMultiprocessorCount, dev) != hipSuccess) { grid = -1; return; }
        if (hipFuncSetAttribute((const void*)fwd_kernel, hipFuncAttributeMaxDynamicSharedMemorySize, LDS_BYTES) != hipSuccess) { fprintf(stderr, "kernel_launch: hipFuncSetAttribute failed\n"); grid = -1; return; }
        int per_cu = 0;
        (void)hipOccupancyMaxActiveBlocksPerMultiprocessor(&per_cu, (const void*)fwd_kernel, 512, LDS_BYTES);
        (void)hipGetLastError();
        grid = cus;
    }
    if (grid < 0) return;
    (void)hipMemsetAsync((char*)d_ws + WS_CTL, 0, CTL_ZERO_BYTES, stream);
    Args a{};
    for (int i = 0; i < 17; ++i) a.in[i] = (const float*)d_in[i];
    a.out = (float*)d_out; a.ws = (unsigned char*)d_ws;
    if (N_LAUNCH == 1) {
        a.ph_lo = 0; a.ph_hi = NPHASE;
        hipLaunchKernelGGL(fwd_kernel, dim3(grid), dim3(512), LDS_BYTES, stream, a);
    } else {
        for (int p = 0; p < NPHASE; ++p) { a.ph_lo = p; a.ph_hi = p + 1; hipLaunchKernelGGL(fwd_kernel, dim3(grid), dim3(512), LDS_BYTES, stream, a); }
    }
}
```

```cpp
#include <hip/hip_runtime.h>
#include <stdint.h>
#include <stdio.h>

typedef unsigned short bf16_t;
typedef short bf16x8 __attribute__((ext_vector_type(8)));
typedef float f32x4 __attribute__((ext_vector_type(4)));
typedef float f32x2 __attribute__((ext_vector_type(2)));
typedef unsigned u32x4 __attribute__((ext_vector_type(4)));
typedef unsigned u32x2 __attribute__((ext_vector_type(2)));
typedef __bf16 bf16x2_t __attribute__((ext_vector_type(2)));

#ifndef N_LAUNCH
#define N_LAUNCH 1
#endif
constexpr int NPHASE = 10;

constexpr int DM = 2048, SEQ = 4096, NTOK = 8192, HD = 128, INW = 6152, QKVW = 6144, NE = 32, FF = 2048;
constexpr float LN_EPS = 1e-5f;
constexpr float ALPHA = 1.189207115002721f;
constexpr float QK_SCALE = 0.08838834764831845f;

constexpr size_t MiB = 1u << 20;
constexpr size_t WS_CTL = 0, CTL_ZERO_BYTES = 1 * MiB;
constexpr size_t WS_MOD = 1 * MiB, WS_LOGF = 2 * MiB, WS_CUM = 3 * MiB, WS_TOPI = 4 * MiB, WS_GATE = 5 * MiB, WS_LIST = 6 * MiB;
constexpr size_t WS_HA = 8 * MiB, WS_QKV = 40 * MiB, WS_MIX = 136 * MiB, WS_Y = 168 * MiB, WS_X1 = 232 * MiB;
constexpr size_t WS_Y2 = 296 * MiB  , WS_PART = 424 * MiB  , WS_LSE = 472 * MiB;
constexpr size_t WS_WINT = 474 * MiB  , WS_WOUTT = 498 * MiB  ;
constexpr size_t WS_WGU8 = 512 * MiB  , WS_WD8 = 768 * MiB  ;
constexpr size_t WS_XS = 896 * MiB  , WS_ACT = 1408 * MiB  , WS_END = 1920 * MiB;
constexpr float SC_ACT = 8.f, SC_WGU = 1024.f, SC_WD = 1792.f;
constexpr size_t WS_XSC = 7 * MiB, WS_HSC = 4 * MiB + 512 * 1024  , WS_MSC = 4 * MiB + 768 * 1024  ;
constexpr size_t WS_MIX8 = 296 * MiB;
constexpr float SC_WIN = 1024.f, SC_WO = 1792.f;
constexpr int CW_BAR = 0;
constexpr int CW_CNT = 4096;
constexpr int CW_ATTQ = 4096 + 64;

constexpr int LDS_BYTES = 147456;
constexpr int LDS_BARW = LDS_BYTES - 16;

#define XB_TMO      128
#define XB_XCNT(j)  (256  + 64 * (j))
#define XB_XSUB(j)  (1280 + 64 * (j))
#define XB_XGEN(j)  (2304 + 64 * (j))
#define XB_TOP      3328
#define XB_TOPGEN   3392
#define XCD_BAR_WORDS 3456
#define XB_SPIN_CAP (1u << 18)
#define LAS __attribute__((address_space(3)))

__device__ __forceinline__ unsigned xb_ld(unsigned* p)              { return __hip_atomic_load(p, __ATOMIC_RELAXED, __HIP_MEMORY_SCOPE_AGENT); }
__device__ __forceinline__ unsigned xb_add(unsigned* p, unsigned v) { return __hip_atomic_fetch_add(p, v, __ATOMIC_RELAXED, __HIP_MEMORY_SCOPE_AGENT); }
__device__ __forceinline__ unsigned xb_xcc_id() { return (unsigned)__builtin_amdgcn_s_getreg((3 << 11) | 20) & 0xFu; }
#define XB_SPIN(cond, bar) do { unsigned _sp = 0; while (cond) { __builtin_amdgcn_s_sleep(1); \
    if ((++_sp & 255u) == 0u) { if (xb_ld(&(bar)[XB_TMO])) break; if (_sp > XB_SPIN_CAP) { atomicAdd(&(bar)[XB_TMO], 1u); break; } } } } while (0)

struct XcdBarrier { unsigned* bar; unsigned x; volatile LAS unsigned* st; };

__device__ __forceinline__ XcdBarrier xcd_barrier_post(unsigned* bar, volatile LAS unsigned* st) {
    XcdBarrier b; b.bar = bar; b.x = xb_xcc_id(); b.st = st;
    if (threadIdx.x == 0) (void)xb_add(&bar[XB_XCNT(b.x)], 1u);
    return b;
}
__device__ __forceinline__ void xcd_barrier_complete(unsigned* bar, unsigned x, unsigned& nloc, unsigned& nx) {
    const unsigned G = gridDim.x * gridDim.y * gridDim.z;
    unsigned sum, cnt, mine, sp = 0u;
    for (;;) {
        sum = 0u; cnt = 0u; mine = 0u;
#pragma unroll
        for (unsigned j = 0; j < 16; ++j) { const unsigned c = xb_ld(&bar[XB_XCNT(j)]); sum += c; cnt += (c > 0u) ? 1u : 0u; mine = (j == x) ? c : mine; }
        if (sum == G) break;
        __builtin_amdgcn_s_sleep(1);
        if ((++sp & 255u) == 0u) { if (xb_ld(&bar[XB_TMO])) break; if (sp > XB_SPIN_CAP) { atomicAdd(&bar[XB_TMO], 1u); break; } }
    }
    nloc = mine > 0u ? mine : 1u; nx = cnt > 0u ? cnt : 1u;
}
__device__ __forceinline__ void xcd_barrier(const XcdBarrier& b) {
    asm volatile("s_waitcnt vmcnt(0)" ::: "memory");
    __syncthreads();
    if (threadIdx.x == 0) {
        unsigned* bar = b.bar;
        __builtin_amdgcn_s_waitcnt(0);
        unsigned nloc = b.st[0], nx = b.st[1];
        if (nloc == 0u) { xcd_barrier_complete(bar, b.x, nloc, nx); b.st[0] = nloc; b.st[1] = nx; }
        const unsigned old = xb_add(&bar[XB_XSUB(b.x)], 1u);
        const unsigned gen = old / nloc;
        if (old + 1u == (gen + 1u) * nloc) {
            __builtin_amdgcn_fence(__ATOMIC_RELEASE, "agent");
            asm volatile("s_waitcnt vmcnt(0)" ::: "memory");
            const unsigned og = xb_add(&bar[XB_TOP], 1u);
            const unsigned tg = og / nx;
            if (og + 1u == (tg + 1u) * nx) xb_add(&bar[XB_TOPGEN], 1u);
            else XB_SPIN(xb_ld(&bar[XB_TOPGEN]) == tg, bar);
            __builtin_amdgcn_fence(__ATOMIC_ACQUIRE, "agent");
            xb_add(&bar[XB_XGEN(b.x)], 1u);
            asm volatile("s_waitcnt vmcnt(0)" ::: "memory");
        } else {
            XB_SPIN(xb_ld(&bar[XB_XGEN(b.x)]) == gen, bar);
            __builtin_amdgcn_fence(__ATOMIC_ACQUIRE, "agent");
            asm volatile("s_waitcnt vmcnt(0)" ::: "memory");
        }
    }
    __syncthreads();
}

__device__ __forceinline__ unsigned cvtpk(float lo, float hi) { f32x2 v = {lo, hi}; bf16x2_t b = __builtin_convertvector(v, bf16x2_t); return __builtin_bit_cast(unsigned, b); }
__device__ __forceinline__ float bf2f(bf16_t v) { return __uint_as_float(((unsigned)v) << 16); }
__device__ __forceinline__ float wave_sum(float v) {
#pragma unroll
    for (int o = 1; o < 64; o <<= 1) v += __shfl_xor(v, o);
    return v;
}
__device__ __forceinline__ float wave_max(float v) {
#pragma unroll
    for (int o = 1; o < 64; o <<= 1) v = fmaxf(v, __shfl_xor(v, o));
    return v;
}

__device__ __forceinline__ unsigned pack_i8x4s(float a, float b, float c, float d, float s) {
    const float MG = 12582912.f, LO = 12582912.f - 127.f, HI = 12582912.f + 127.f;
    const unsigned ta = __float_as_uint(__builtin_amdgcn_fmed3f(__builtin_fmaf(a, s, MG), LO, HI)), tb = __float_as_uint(__builtin_amdgcn_fmed3f(__builtin_fmaf(b, s, MG), LO, HI));
    const unsigned tc = __float_as_uint(__builtin_amdgcn_fmed3f(__builtin_fmaf(c, s, MG), LO, HI)), td = __float_as_uint(__builtin_amdgcn_fmed3f(__builtin_fmaf(d, s, MG), LO, HI));
    const unsigned lo = __builtin_amdgcn_perm(tb, ta, 0x0c0c0400u), hi = __builtin_amdgcn_perm(td, tc, 0x0c0c0400u);
    return __builtin_amdgcn_perm(hi, lo, 0x05040100u);
}
__device__ __forceinline__ unsigned pack_i8x4(float a, float b, float c, float d) { return pack_i8x4s(a, b, c, d, 1.f); }
__device__ __forceinline__ unsigned pack_fp8x4(float a, float b, float c, float d) {
    a = __builtin_amdgcn_fmed3f(a, -448.f, 448.f); b = __builtin_amdgcn_fmed3f(b, -448.f, 448.f); c = __builtin_amdgcn_fmed3f(c, -448.f, 448.f); d = __builtin_amdgcn_fmed3f(d, -448.f, 448.f);
    int p = __builtin_amdgcn_cvt_pk_fp8_f32(a, b, 0, false); p = __builtin_amdgcn_cvt_pk_fp8_f32(c, d, p, true); return (unsigned)p;
}
struct Args { const float* in[17]; float* out; unsigned char* ws; int ph_lo, ph_hi; };

__device__ __forceinline__ void phase_ada(const Args& a, unsigned char* lds, int tid) {
    float* cond = (float*)lds;
    float* red = (float*)(lds + 16384);
    for (int i = tid; i < 4096; i += 512) { const float c = a.in[1][i]; cond[i] = c / (1.f + expf(-c)); }
    __syncthreads();
    const float* w_ada = a.in[2]; const float* b_ada = a.in[3];
    float* mod = (float*)(a.ws + WS_MOD);
    for (int cg = blockIdx.x; cg < 256; cg += gridDim.x) {
        const int col4 = tid % 12, slot = tid / 12;
        if (slot < 42) {
            f32x4 a0 = {0.f, 0.f, 0.f, 0.f}, a1 = {0.f, 0.f, 0.f, 0.f};
            const float* wp = w_ada + cg * 48 + col4 * 4;
#pragma unroll 7
            for (int k = slot; k < 2048; k += 42) {
                const f32x4 w = __builtin_nontemporal_load((const f32x4*)(wp + (size_t)k * 12288));
                a0 += cond[k] * w; a1 += cond[2048 + k] * w;
            }
            float* r = red + (slot * 12 + col4) * 8;
            *(f32x4*)r = a0; *(f32x4*)(r + 4) = a1;
        }
        __syncthreads();
        if (tid < 96) {
            const int b = tid / 48, col = tid % 48; float s = 0.f;
            for (int sl = 0; sl < 42; ++sl) s += red[(sl * 12 + (col >> 2)) * 8 + b * 4 + (col & 3)];
            mod[b * 12288 + cg * 48 + col] = s + b_ada[cg * 48 + col];
        }
        __syncthreads();
    }
}

__device__ __forceinline__ void phase_mod1_stage(const Args& a, unsigned char* lds, int tid) {
    float* Wj = (float*)lds;
    const float* w_in = a.in[4];
    for (int k = tid; k < 2048; k += 512) {
        const float* p = w_in + (size_t)k * INW + 6144;
        const f32x4 u = *(const f32x4*)p, v = *(const f32x4*)(p + 4);
        Wj[0 * 2048 + k] = u.x; Wj[1 * 2048 + k] = u.y; Wj[2 * 2048 + k] = u.z; Wj[3 * 2048 + k] = u.w;
        Wj[4 * 2048 + k] = v.x; Wj[5 * 2048 + k] = v.y; Wj[6 * 2048 + k] = v.z; Wj[7 * 2048 + k] = v.w;
    }
    __syncthreads();
}
__device__ __forceinline__ void phase_mod1(const Args& a, unsigned char* lds, int tid, int wid, int lane) {
    float* Wj = (float*)lds;
    const float* w_in = a.in[4]; (void)w_in;
    const float* x = a.in[0]; const float* mod = (const float*)(a.ws + WS_MOD); const float* bfo = a.in[5];
    unsigned char* HA = a.ws + WS_HA; float* HSC = (float*)(a.ws + WS_HSC); float* LOGF = (float*)(a.ws + WS_LOGF);
    for (int rg = blockIdx.x * 8 + wid; rg < 2048; rg += gridDim.x * 8) {
        const int row0 = rg * 4, b = row0 >> 12;
        const float* sh = mod + b * 12288; const float* sc = sh + 2048;
        float acc[4][8], am[4];
#pragma unroll
        for (int r = 0; r < 4; ++r) { am[r] = 0.f;
#pragma unroll
            for (int j = 0; j < 8; ++j) acc[r][j] = 0.f; }
        f32x4 xc[4], shc, scc;
        { const int k0 = 4 * lane; shc = *(const f32x4*)(sh + k0); scc = *(const f32x4*)(sc + k0);
#pragma unroll
          for (int r = 0; r < 4; ++r) xc[r] = *(const f32x4*)(x + (size_t)(row0 + r) * DM + k0); }
#pragma unroll 1
        for (int i = 0; i < 8; ++i) {
            const int k0 = 4 * lane + 256 * i, k1 = 4 * lane + 256 * ((i + 1) & 7);
            const f32x4 shn = *(const f32x4*)(sh + k1), scn = *(const f32x4*)(sc + k1);
            f32x4 xn[4];
#pragma unroll
            for (int r = 0; r < 4; ++r) xn[r] = *(const f32x4*)(x + (size_t)(row0 + r) * DM + k1);
            const f32x4 shv = shc; f32x4 scv = scc; scv += 1.f;
            f32x4 w[8];
#pragma unroll
            for (int j = 0; j < 8; ++j) w[j] = *(const f32x4*)(Wj + j * 2048 + k0);
#pragma unroll
            for (int r = 0; r < 4; ++r) {
                const f32x4 xv = xc[r];
                const f32x4 h = xv * scv + shv;
                am[r] = fmaxf(am[r], fmaxf(fmaxf(fabsf(h.x), fabsf(h.y)), fmaxf(fabsf(h.z), fabsf(h.w))));
#pragma unroll
                for (int j = 0; j < 8; ++j) acc[r][j] += (h.x * w[j].x + h.y * w[j].y) + (h.z * w[j].z + h.w * w[j].w);
            }
            shc = shn; scc = scn;
#pragma unroll
            for (int r = 0; r < 4; ++r) xc[r] = xn[r];
        }
        float qs[4];
#pragma unroll
        for (int r = 0; r < 4; ++r) { const float m = fmaxf(wave_max(am[r]), 1e-20f); qs[r] = 127.f / m; if (lane == 0) HSC[row0 + r] = m * (1.f / 127.f); }
#pragma unroll 1
        for (int i = 0; i < 8; ++i) {
            const int k0 = 4 * lane + 256 * i, k1 = 4 * lane + 256 * ((i + 1) & 7);
            const f32x4 shn = *(const f32x4*)(sh + k1), scn = *(const f32x4*)(sc + k1);
            f32x4 xn[4];
#pragma unroll
            for (int r = 0; r < 4; ++r) xn[r] = *(const f32x4*)(x + (size_t)(row0 + r) * DM + k1);
            const f32x4 shv = shc; f32x4 scv = scc; scv += 1.f;
#pragma unroll
            for (int r = 0; r < 4; ++r) {
                const f32x4 h = xc[r] * scv + shv;
                *(unsigned*)(HA + (size_t)(row0 + r) * DM + k0) = pack_i8x4s(h.x, h.y, h.z, h.w, qs[r]);
            }
            shc = shn; scc = scn;
#pragma unroll
            for (int r = 0; r < 4; ++r) xc[r] = xn[r];
        }
        float mine = 0.f;
#pragma unroll
        for (int r = 0; r < 4; ++r)
#pragma unroll
            for (int j = 0; j < 8; ++j) { const float s = wave_sum(acc[r][j]); if (lane == r * 8 + j) mine = s; }
        if (lane < 32) {
            const int r = lane >> 3, j = lane & 7;
            const float z = mine + bfo[j];
            LOGF[(size_t)(row0 + r) * 8 + j] = fminf(z, 0.f) - log1pf(expf(-fabsf(z)));
        }
    }
}

__device__ __forceinline__ void phase_cumsum(const Args& a, unsigned char* lds, int tid, int wid, int lane) {
    const float* LOGF = (const float*)(a.ws + WS_LOGF); float* CUM = (float*)(a.ws + WS_CUM);
    float* wtot = (float*)(lds + 131072);
    for (int s = blockIdx.x; s < 16; s += gridDim.x) {
        const int b = s >> 3, h = s & 7;
        float v[8]; float run = 0.f;
#pragma unroll
        for (int i = 0; i < 8; ++i) { const int t = tid * 8 + i; run += LOGF[(size_t)(b * SEQ + t) * 8 + h]; v[i] = run; }
        float tot = run;
#pragma unroll
        for (int o = 1; o < 64; o <<= 1) { const float n = __shfl_up(tot, o); if (lane >= o) tot += n; }
        if (lane == 63) wtot[wid] = tot;
        __syncthreads();
        float base = 0.f;
#pragma unroll
        for (int w = 0; w < 8; ++w) if (w < wid) base += wtot[w];
        const float excl = base + tot - run;
#pragma unroll
        for (int i = 0; i < 8; ++i) CUM[s * SEQ + tid * 8 + i] = (excl + v[i]) * 1.4426950408889634f;
        __syncthreads();
    }
}

__device__ __forceinline__ int swz_off(int row, int chunk) { return row * 128 + (((chunk ^ (row >> 1) ^ ((row >> 4) & 1)) & 7) << 4); }
namespace pg8 {
typedef int i32x4v __attribute__((ext_vector_type(4)));
constexpr int BM = 256, BK = 64, HALF = 128, HTB = HALF * BK * 2;
__device__ __forceinline__ int lds_byte(int r, int c) { const int st = (r >> 4) * 2 + (c >> 5), rr = r & 15, cc = c & 31, ob = rr * 64 + cc * 2; return st * 1024 + (ob ^ (((ob >> 9) & 1) << 5)); }
__device__ __forceinline__ int perm32(int rho) { const int n = rho >> 4, i = rho & 15; return 8 * (i >> 2) + 4 * n + (i & 3); }
__device__ __forceinline__ void stage_rc(int b, int& R, int& C) { const int st = b / 1024, sb = b % 1024, swz = sb ^ (((sb >> 9) & 1) << 5); R = (st >> 1) * 16 + swz / 64; C = (st & 1) * 32 + (swz % 64) / 2; }
struct Unit { int pm, pn, na; };
struct Gemm { const bf16_t* A; const bf16_t* Bt; int K; };
template <bool FP8, class Epi, class Sched, bool ALIGN_EPI>
__device__ __forceinline__ void gemm_phase(LAS unsigned char* lds, const Gemm g, const Sched& S, const Epi& E) {
    const int tid = threadIdx.x, wid = __builtin_amdgcn_readfirstlane(tid >> 6), lane = tid & 63, wr = wid >> 2, wc = wid & 3, fr = lane & 15, fq = lane >> 4;
    const int K = g.K, nt = K / BK;
    unsigned voffA[2], voffB[2];
#pragma unroll
    for (int i = 0; i < 2; ++i) { int R, C; stage_rc(tid * 16 + i * 8192, R, C); const int Rb = (R & ~31) + perm32(R & 31); voffA[i] = (unsigned)(R * K + C) * 2u; voffB[i] = (unsigned)(Rb * K + C) * 2u; }
    const size_t kstep = (size_t)(BK * 2);
    const size_t hstep = (size_t)HALF * K * 2;
    const size_t tstep = 2 * hstep;
    const unsigned ldsw = (unsigned)wid * 1024u;
    const int aoff = lds_byte(wr * 64 + fr, fq * 8), boff = lds_byte(wc * 32 + fr, fq * 8);
#define PG8_SA(b, h) (((b) * 2 + (h)) * HTB)
#define PG8_SB(b, h) ((4 + (b) * 2 + (h)) * HTB)
#define PG8_STAGE(bufoff, gbase, voff) do { _Pragma("unroll") for (int _i = 0; _i < 2; ++_i) \
        __builtin_amdgcn_global_load_lds((const unsigned*)((const char*)(gbase) + (voff)[_i]), (LAS unsigned*)(lds + (bufoff) + ldsw + _i * 8192), 16, 0, 0); } while (0)
#define PG8_STAGE_A(bufoff, gbase, h, nav) do { _Pragma("unroll") for (int _i = 0; _i < 2; ++_i) if (lane == 0 || 2 * (h) + _i < (nav)) \
        __builtin_amdgcn_global_load_lds((const unsigned*)((const char*)(gbase) + voffA[_i]), (LAS unsigned*)(lds + (bufoff) + ldsw + _i * 8192), 16, 0, 0); } while (0)
#define PG8_LDA(dst, b, h) do { _Pragma("unroll") for (int m = 0; m < 4; ++m) _Pragma("unroll") for (int k = 0; k < 2; ++k) dst[m][k] = *(const LAS bf16x8*)(lds + PG8_SA(b, h) + aoff + m * 2048 + k * 1024); } while (0)
#define PG8_LDB(dst, b, h) do { _Pragma("unroll") for (int n = 0; n < 2; ++n) _Pragma("unroll") for (int k = 0; k < 2; ++k) dst[n][k] = *(const LAS bf16x8*)(lds + PG8_SB(b, h) + boff + n * 2048 + k * 1024); } while (0)
#define PG8_MMA(ai, bj, At, Bt) do { __builtin_amdgcn_s_setprio(1); _Pragma("unroll") for (int m = 0; m < 4; ++m) _Pragma("unroll") for (int n = 0; n < 2; ++n) _Pragma("unroll") for (int k = 0; k < 2; ++k) { \
        if (FP8) acc[ai][bj][m][n] = __builtin_bit_cast(f32x4, __builtin_amdgcn_mfma_i32_16x16x64_i8(__builtin_bit_cast(i32x4v, Bt[n][k]), __builtin_bit_cast(i32x4v, At[m][k]), __builtin_bit_cast(i32x4v, acc[ai][bj][m][n]), 0, 0, 0)); \
        else acc[ai][bj][m][n] = __builtin_amdgcn_mfma_f32_16x16x32_bf16(Bt[n][k], At[m][k], acc[ai][bj][m][n], 0, 0, 0); } __builtin_amdgcn_s_setprio(0); } while (0)
#define PG8_WAIT_V(n) asm volatile("s_waitcnt vmcnt(" #n ")" ::: "memory")
#define PG8_WAIT_L(n) asm volatile("s_waitcnt lgkmcnt(" #n ")" ::: "memory")
#define PG8_BAR __builtin_amdgcn_s_barrier()
#define PG8_SCHED __builtin_amdgcn_sched_barrier(0)
    Unit cur, nxt; int ui = 0;
    if (!S.next(0, cur)) return;
    f32x4 acc[2][2][4][2];
#pragma unroll
    for (int a = 0; a < 2; ++a)
#pragma unroll
        for (int b = 0; b < 2; ++b)
#pragma unroll
            for (int m = 0; m < 4; ++m)
#pragma unroll
                for (int n = 0; n < 2; ++n) acc[a][b][m][n] = (f32x4){0.f, 0.f, 0.f, 0.f};
    bf16x8 At[4][2], B0[2][2], B1[2][2];
    const char* cA = (const char*)g.A + (size_t)cur.pm * tstep; const char* cB = (const char*)g.Bt + (size_t)cur.pn * tstep;
    PG8_STAGE(PG8_SB(0, 0), cB, voffB); PG8_STAGE(PG8_SB(0, 1), cB + hstep, voffB); PG8_STAGE_A(PG8_SA(0, 0), cA, 0, cur.na); PG8_STAGE_A(PG8_SA(0, 1), cA + hstep, 1, cur.na);
    if (wr == 1) PG8_BAR;
    PG8_WAIT_V(2); PG8_BAR;
    PG8_STAGE(PG8_SB(1, 0), cB + kstep, voffB); PG8_STAGE_A(PG8_SA(1, 0), cA + kstep, 0, cur.na); PG8_STAGE(PG8_SB(1, 1), cB + hstep + kstep, voffB);
    PG8_WAIT_V(6); PG8_BAR;
    for (;;) {
        const bool has_next = S.next(ui + 1, nxt);
        const char* nA = has_next ? (const char*)g.A + (size_t)nxt.pm * tstep : cA; const char* nB = has_next ? (const char*)g.Bt + (size_t)nxt.pn * tstep : cB;
        const int cna = cur.na, nna = has_next ? nxt.na : cur.na;
        const bool do0 = cna > wr, do1 = cna > 2 + wr;
        if (!Sched::HAS_LIGHT || (cna == 4 && nna == 4)) {
        for (int t = 0; t < nt; t += 2) {
            const bool last = (t == nt - 2);
            const char* a1 = cA + (size_t)(t + 1) * kstep;
            const char* a2 = last ? nA : cA + (size_t)(t + 2) * kstep; const char* b2 = last ? nB : cB + (size_t)(t + 2) * kstep;
            const char* a3 = a2 + kstep; const char* b3 = b2 + kstep;
            PG8_LDB(B0, 0, 0); PG8_LDB(B1, 0, 1); PG8_SCHED; PG8_LDA(At, 0, 0); PG8_STAGE(PG8_SA(1, 1), a1 + hstep, voffA);
            PG8_WAIT_V(8); PG8_WAIT_L(0); PG8_BAR; PG8_MMA(0, 0, At, B0); PG8_MMA(0, 1, At, B1); PG8_BAR; PG8_SCHED;
            PG8_LDA(At, 0, 1); PG8_STAGE(PG8_SB(0, 0), b2, voffB); PG8_STAGE(PG8_SB(0, 1), b2 + hstep, voffB); PG8_STAGE(PG8_SA(0, 0), a2, voffA);
            PG8_WAIT_V(8); PG8_WAIT_L(0); PG8_BAR; PG8_MMA(1, 0, At, B0); PG8_MMA(1, 1, At, B1); PG8_BAR; PG8_SCHED;
            PG8_LDB(B0, 1, 0); PG8_LDB(B1, 1, 1); PG8_SCHED; PG8_LDA(At, 1, 0); PG8_STAGE(PG8_SA(0, 1), a2 + hstep, voffA);
            PG8_WAIT_V(8); PG8_WAIT_L(0); PG8_BAR; PG8_MMA(0, 0, At, B0); PG8_MMA(0, 1, At, B1); PG8_BAR; PG8_SCHED;
            PG8_LDA(At, 1, 1); PG8_STAGE(PG8_SB(1, 0), b3, voffB); PG8_STAGE(PG8_SB(1, 1), b3 + hstep, voffB); PG8_STAGE(PG8_SA(1, 0), a3, voffA);
            PG8_WAIT_V(8); PG8_WAIT_L(0); PG8_BAR; PG8_MMA(1, 0, At, B0); PG8_MMA(1, 1, At, B1); PG8_BAR; PG8_SCHED;
        }
        } else {
        for (int t = 0; t < nt; t += 2) {
            const bool last = (t == nt - 2);
            const char* a1 = cA + (size_t)(t + 1) * kstep;
            const char* a2 = last ? nA : cA + (size_t)(t + 2) * kstep; const char* b2 = last ? nB : cB + (size_t)(t + 2) * kstep;
            const char* a3 = a2 + kstep; const char* b3 = b2 + kstep;
            const int na2 = last ? nna : cna;
            PG8_LDB(B0, 0, 0); PG8_LDB(B1, 0, 1); PG8_SCHED; PG8_LDA(At, 0, 0); PG8_STAGE_A(PG8_SA(1, 1), a1 + hstep, 1, cna);
            PG8_WAIT_V(8); PG8_WAIT_L(0); PG8_BAR; if (do0) { PG8_MMA(0, 0, At, B0); PG8_MMA(0, 1, At, B1); } PG8_BAR; PG8_SCHED;
            if (do1) PG8_LDA(At, 0, 1); PG8_STAGE(PG8_SB(0, 0), b2, voffB); PG8_STAGE(PG8_SB(0, 1), b2 + hstep, voffB); PG8_STAGE_A(PG8_SA(0, 0), a2, 0, na2);
            PG8_WAIT_V(8); PG8_WAIT_L(0); PG8_BAR; if (do1) { PG8_MMA(1, 0, At, B0); PG8_MMA(1, 1, At, B1); } PG8_BAR; PG8_SCHED;
            PG8_LDB(B0, 1, 0); PG8_LDB(B1, 1, 1); PG8_SCHED; PG8_LDA(At, 1, 0); PG8_STAGE_A(PG8_SA(0, 1), a2 + hstep, 1, na2);
            PG8_WAIT_V(8); PG8_WAIT_L(0); PG8_BAR; if (do0) { PG8_MMA(0, 0, At, B0); PG8_MMA(0, 1, At, B1); } PG8_BAR; PG8_SCHED;
            if (do1) PG8_LDA(At, 1, 1); PG8_STAGE(PG8_SB(1, 0), b3, voffB); PG8_STAGE(PG8_SB(1, 1), b3 + hstep, voffB); PG8_STAGE_A(PG8_SA(1, 0), a3, 0, na2);
            PG8_WAIT_V(8); PG8_WAIT_L(0); PG8_BAR; if (do1) { PG8_MMA(1, 0, At, B0); PG8_MMA(1, 1, At, B1); } PG8_BAR; PG8_SCHED;
        }
        }
        if constexpr (ALIGN_EPI) { if (wr == 0) PG8_BAR; }
        { int ln_ = (int)__builtin_amdgcn_mbcnt_hi(~0u, __builtin_amdgcn_mbcnt_lo(~0u, 0u)); asm volatile("" : "+v"(ln_)); const int fr_ = ln_ & 15, fq_ = ln_ >> 4;
          E(acc, cur, wr, wc, fr_, fq_); }
        if (!has_next) break;
#pragma unroll
        for (int a = 0; a < 2; ++a)
#pragma unroll
            for (int b = 0; b < 2; ++b)
#pragma unroll
                for (int m = 0; m < 4; ++m)
#pragma unroll
                    for (int n = 0; n < 2; ++n) acc[a][b][m][n] = (f32x4){0.f, 0.f, 0.f, 0.f};
        cur = nxt; cA = nA; cB = nB; ++ui;
        if constexpr (ALIGN_EPI) { if (wr == 1) PG8_BAR; }
    }
    PG8_WAIT_V(0);
    if constexpr (!ALIGN_EPI) { if (wr == 0) PG8_BAR; }
    PG8_BAR;
#undef PG8_SA
#undef PG8_SB
#undef PG8_STAGE
#undef PG8_STAGE_A
#undef PG8_LDA
#undef PG8_LDB
#undef PG8_MMA
#undef PG8_WAIT_V
#undef PG8_WAIT_L
#undef PG8_BAR
#undef PG8_SCHED
}
}

struct SchedDense {
    static constexpr bool HAS_LIGHT = false;
    int nN, G, vcu, rf;
    __device__ __forceinline__ bool next(int i, pg8::Unit& u) const {
        if (G == 256) { const int rounds = nN >> 3; if (i >= rounds * rf) return false; i = i % rounds;
            const int k = vcu >> 5, j = vcu & 31; u.pm = 8 * (k & 3) + (j & 7); u.pn = 8 * i + 4 * (k >> 2) + (j >> 3); u.na = 4; return true; }
        const int L = i * G + vcu; if (L >= 32 * nN) return false; u.pm = L & 31; u.pn = L >> 5; u.na = 4; return true;
    }
};
struct SchedList {
    static constexpr bool HAS_LIGHT = true;
    const int* ul; int n;
    __device__ __forceinline__ bool next(int i, pg8::Unit& u) const {
        if (i >= n) return false;
        const int v = __builtin_amdgcn_readfirstlane(ul[i]); u.pm = v >> 16; u.pn = v & 0xfff; u.na = (v >> 12) & 7; return true;
    }
};
__device__ __forceinline__ int build_moe_list(int* ul, const int* tb, const int* cn, int NCT, int G, int vcu, int rf, int tid) {
    const int* hb = tb + 160; const int* lb = tb + 200;
    const int H = hb[NE] * NCT, Lt = lb[NE] * NCT;
    const int nh = (H > vcu) ? (H - vcu + G - 1) / G : 0, nl = (Lt > vcu) ? (Lt - vcu + G - 1) / G : 0;
    const int n1 = nh + nl, n = n1 * rf;
    if (tid < n && tid < 64) {
        const int p = tid % n1, kpos = min((vcu * 8) / G, nh), has_l = nl > 0;
        int e = 0, ct, rt, light, idx;
        if (has_l && p == kpos) { light = 1; idx = vcu; }
        else if (p < nh + has_l) { light = 0; idx = vcu + (p - ((has_l && p > kpos) ? 1 : 0)) * G; }
        else { light = 1; idx = vcu + (p - nh) * G; }
        if (light) { for (int q = 1; q < NE; ++q) if (idx >= lb[q] * NCT) e = q; ct = idx - lb[e] * NCT; rt = tb[e + 1] - tb[e] - 1; }
        else { for (int q = 1; q < NE; ++q) if (idx >= hb[q] * NCT) e = q; const int nh_e = hb[e + 1] - hb[e], loc = idx - hb[e] * NCT; ct = loc / nh_e; rt = loc - ct * nh_e; }
        const int rows = cn[e] - rt * 256, na = rows >= 256 ? 4 : (rows + 63) >> 6;
        ul[tid] = ((e * 32 + rt) << 16) | (na << 12) | (e * NCT + ct);
    }
    __syncthreads();
    return n < 64 ? n : 64;
}

__device__ __forceinline__ f32x4 i2f(const f32x4& v) { const pg8::i32x4v i = __builtin_bit_cast(pg8::i32x4v, v); return (f32x4){(float)i[0], (float)i[1], (float)i[2], (float)i[3]}; }
struct EpiQKV {
    bf16_t* O; const float* hsc;
    __device__ __forceinline__ void operator()(const f32x4 (&acc)[2][2][4][2], const pg8::Unit& u, int wr, int wc, int fr, int fq) const {
        float hs8[2][4];
#pragma unroll
        for (int ai = 0; ai < 2; ++ai)
#pragma unroll
            for (int m = 0; m < 4; ++m) hs8[ai][m] = hsc[u.pm * 256 + ai * 128 + wr * 64 + m * 16 + fr];
#pragma unroll
        for (int ai = 0; ai < 2; ++ai)
#pragma unroll
            for (int m = 0; m < 4; ++m) {
                const int row = u.pm * 256 + ai * 128 + wr * 64 + m * 16 + fr;
                const float rs = hs8[ai][m] * (1.f / SC_WIN) * ((u.pn < 4 || (u.pn >= 12 && u.pn < 16)) ? QK_SCALE * 1.4426950408889634f : 1.f);
                bf16_t* rowp = O + (size_t)row * QKVW + u.pn * 256 + wc * 32 + 8 * fq;
#pragma unroll
                for (int bj = 0; bj < 2; ++bj) { const f32x4 v0 = i2f(acc[ai][bj][m][0]) * rs, v1 = i2f(acc[ai][bj][m][1]) * rs; u32x4 o; o.x = cvtpk(v0.x, v0.y); o.y = cvtpk(v0.z, v0.w); o.z = cvtpk(v1.x, v1.y); o.w = cvtpk(v1.z, v1.w); *(u32x4*)(rowp + bj * 128) = o; }
            }
    }
};
struct EpiOut {
    bf16_t* Y; const float* x; const float* mod; const float* msc;
    __device__ __forceinline__ void operator()(const f32x4 (&acc)[2][2][4][2], const pg8::Unit& u, int wr, int wc, int fr, int fq) const {
        const float* ga = mod + ((u.pm * 256) >> 12) * 12288 + 2 * 2048;
#pragma unroll
        for (int ai = 0; ai < 2; ++ai)
#pragma unroll
            for (int m = 0; m < 4; ++m) {
                const int row = u.pm * 256 + ai * 128 + wr * 64 + m * 16 + fr;
                const float rs = msc[row] * (1.f / SC_WO);
#pragma unroll
                for (int bj = 0; bj < 2; ++bj) {
                    const int col = u.pn * 256 + bj * 128 + wc * 32 + 8 * fq;
                    const size_t off = (size_t)row * DM + col;
                    const f32x4 y0 = ALPHA * *(const f32x4*)(x + off) + *(const f32x4*)(ga + col) * (i2f(acc[ai][bj][m][0]) * rs);
                    const f32x4 y1 = ALPHA * *(const f32x4*)(x + off + 4) + *(const f32x4*)(ga + col + 4) * (i2f(acc[ai][bj][m][1]) * rs);
                    u32x4 w; w.x = cvtpk(y0.x, y0.y); w.y = cvtpk(y0.z, y0.w); w.z = cvtpk(y1.x, y1.y); w.w = cvtpk(y1.z, y1.w);
                    *(u32x4*)(Y + off) = w;
                }
            }
    }
};
struct EpiGlu {
    unsigned char* ACT; const float* bgu; const int* cn; const float* xsc;
    __device__ __forceinline__ void operator()(const f32x4 (&acc)[2][2][4][2], const pg8::Unit& u, int wr, int wc, int fr, int fq) const {
        const int e = u.pm >> 5, rt = u.pm & 31, ct = u.pn & 15, nvalid = cn[e] - rt * 256;
        const int col = ct * 128 + wc * 32 + 8 * fq;
        f32x4 bg[2], bu[2];
#pragma unroll
        for (int n = 0; n < 2; ++n) { bg[n] = *(const f32x4*)(bgu + (size_t)e * 2 * FF + col + 4 * n); bu[n] = *(const f32x4*)(bgu + (size_t)e * 2 * FF + FF + col + 4 * n); }
        float xs8[2][4];
#pragma unroll
        for (int ai = 0; ai < 2; ++ai)
#pragma unroll
            for (int m = 0; m < 4; ++m) xs8[ai][m] = xsc[u.pm * 256 + ai * 128 + wr * 64 + m * 16 + fr];
#pragma unroll
        for (int n = 0; n < 2; ++n) asm volatile("" :: "v"(bg[n]), "v"(bu[n]));
#pragma unroll
        for (int ai = 0; ai < 2; ++ai)
#pragma unroll
            for (int m = 0; m < 4; ++m) asm volatile("" :: "v"(xs8[ai][m]));
#pragma unroll
        for (int ai = 0; ai < 2; ++ai)
#pragma unroll
            for (int m = 0; m < 4; ++m) {
                const int r = ai * 128 + wr * 64 + m * 16 + fr;
                const float rs = xs8[ai][m] * (1.f / SC_WGU);
                u32x2 w;
#pragma unroll
                for (int n = 0; n < 2; ++n) {
                    const f32x4 g = i2f(acc[ai][0][m][n]) * rs + bg[n], uu = i2f(acc[ai][1][m][n]) * rs + bu[n]; f32x4 o;
#pragma unroll
                    for (int j = 0; j < 4; ++j) {
                        const float gj = fminf(g[j], 7.f), uj = __builtin_amdgcn_fmed3f(uu[j], -7.f, 7.f);
                        o[j] = (uj + 1.f) * (gj * __builtin_amdgcn_rcpf(1.f + __builtin_amdgcn_exp2f(-1.702f * 1.4426950408889634f * gj)));
                    }
                    w[n] = pack_i8x4s(o.x, o.y, o.z, o.w, SC_ACT);
                }
                if (r < nvalid) *(u32x2*)(ACT + (size_t)(u.pm * 256 + r) * FF + col) = w;
            }
    }
};
struct EpiDown {
    unsigned char* Y2; const float* bd; const int* list; const float* gate; const int* cn;
    __device__ __forceinline__ void operator()(const f32x4 (&acc)[2][2][4][2], const pg8::Unit& u, int wr, int wc, int fr, int fq) const {
        const int e = u.pm >> 5, rt = u.pm & 31, ct = u.pn & 7, nvalid = cn[e] - rt * 256;
        const float inv = 1.f / (SC_ACT * SC_WD);
        int aid8[2][4]; float gt8[2][4];
#pragma unroll
        for (int ai = 0; ai < 2; ++ai)
#pragma unroll
            for (int m = 0; m < 4; ++m) { const int r = ai * 128 + wr * 64 + m * 16 + fr; aid8[ai][m] = (r < nvalid) ? list[e * NTOK + rt * 256 + r] : 0; }
#pragma unroll
        for (int ai = 0; ai < 2; ++ai)
#pragma unroll
            for (int m = 0; m < 4; ++m) gt8[ai][m] = gate[aid8[ai][m]];
        f32x4 bdv[2][2];
#pragma unroll
        for (int bj = 0; bj < 2; ++bj) { const int col = ct * 256 + bj * 128 + wc * 32 + 8 * fq; bdv[bj][0] = *(const f32x4*)(bd + (size_t)e * DM + col); bdv[bj][1] = *(const f32x4*)(bd + (size_t)e * DM + col + 4); }
#pragma unroll
        for (int bj = 0; bj < 2; ++bj) asm volatile("" :: "v"(bdv[bj][0]), "v"(bdv[bj][1]));
#pragma unroll
        for (int ai = 0; ai < 2; ++ai)
#pragma unroll
            for (int m = 0; m < 4; ++m) asm volatile("" :: "v"(gt8[ai][m]));
#pragma unroll
        for (int ai = 0; ai < 2; ++ai)
#pragma unroll
            for (int m = 0; m < 4; ++m) {
                const int r = ai * 128 + wr * 64 + m * 16 + fr;
                if (r < nvalid) {
                    const int aid = aid8[ai][m]; const float gt = gt8[ai][m];
#pragma unroll
                    for (int bj = 0; bj < 2; ++bj) {
                        const int col = ct * 256 + bj * 128 + wc * 32 + 8 * fq;
                        const f32x4 v0 = (i2f(acc[ai][bj][m][0]) * inv + bdv[bj][0]) * gt;
                        const f32x4 v1 = (i2f(acc[ai][bj][m][1]) * inv + bdv[bj][1]) * gt;
                        u32x2 w; w.x = pack_fp8x4(v0.x, v0.y, v0.z, v0.w); w.y = pack_fp8x4(v1.x, v1.y, v1.z, v1.w);
                        *(u32x2*)(Y2 + (size_t)aid * DM + col) = w;
                    }
                }
            }
    }
};

template <bool FP8, bool NT>
__device__ __forceinline__ void conv_load(f32x4 (&v)[FP8 ? 16 : 8], const float* W, int ldw, int k0, int srccol, int wid) {
    constexpr int RPW = FP8 ? 16 : 8;
#pragma unroll
    for (int j = 0; j < RPW; ++j) { const f32x4* p = (const f32x4*)(W + (size_t)(k0 + wid * RPW + j) * ldw + srccol); v[j] = NT ? __builtin_nontemporal_load(p) : *p; }
}
template <bool FP8>
__device__ __forceinline__ void conv_store(const f32x4 (&v)[FP8 ? 16 : 8], unsigned char* img, unsigned char* dst, size_t dst_pitch, float scale, int tid, int wid, int lane, int hi_extra = 0) {
    constexpr int RPW = FP8 ? 16 : 8;
#pragma unroll
    for (int i = 0; i < 4; ++i) {
        u32x4 o;
        if (FP8) {
            o.x = pack_i8x4s(v[0][i], v[1][i], v[2][i], v[3][i], scale); o.y = pack_i8x4s(v[4][i], v[5][i], v[6][i], v[7][i], scale);
            o.z = pack_i8x4s(v[8 % RPW][i], v[9 % RPW][i], v[10 % RPW][i], v[11 % RPW][i], scale); o.w = pack_i8x4s(v[12 % RPW][i], v[13 % RPW][i], v[14 % RPW][i], v[15 % RPW][i], scale);
        } else { o.x = cvtpk(v[0][i], v[1][i]); o.y = cvtpk(v[2][i], v[3][i]); o.z = cvtpk(v[4][i], v[5][i]); o.w = cvtpk(v[6][i], v[7][i]); }
        *(u32x4*)(img + swz_off(4 * lane + i, wid)) = o;
    }
    __syncthreads();
#pragma unroll
    for (int i = 0; i < 4; ++i) {
        const int n = (tid >> 3) + 64 * i, c = tid & 7;
        __builtin_nontemporal_store(*(const u32x4*)(img + swz_off(n, c)), (u32x4*)(dst + (size_t)(n + (n >> 7) * hi_extra) * dst_pitch + 16 * c));
    }
    __syncthreads();
}
template <bool FP8, bool NT>
__device__ __forceinline__ void conv_item(unsigned char* img, const float* W, int ldw, int k0, int srccol, unsigned char* dst, size_t dst_pitch, float scale, int tid, int wid, int lane) {
    f32x4 v[FP8 ? 16 : 8];
    conv_load<FP8, NT>(v, W, ldw, k0, srccol, wid);
    conv_store<FP8>(v, img, dst, dst_pitch, scale, tid, wid, lane);
}
__device__ __forceinline__ void phase_convert_dense(const Args& a, unsigned char* lds, int tid, int wid, int lane) {
    unsigned char* img = lds + 32768;
    constexpr int I_IN = 16 * 24, I_OUT = 16 * 8;
    for (int it = blockIdx.x; it < I_IN + I_OUT; it += gridDim.x) {
        int r = it;
        if (r < I_IN) { const int kb = r / 24, nb = r % 24;
            conv_item<true, false>(img, a.in[4], INW, kb * 128, nb * 256 + 4 * lane, a.ws + WS_WINT + ((size_t)(nb * 256) * DM + kb * 128), (size_t)DM, SC_WIN, tid, wid, lane); continue; }
        r -= I_IN;
        { const int kb = r / 8, nb = r % 8;
            conv_item<true, false>(img, a.in[6], DM, kb * 128, nb * 256 + 4 * lane, a.ws + WS_WOUTT + ((size_t)(nb * 256) * DM + kb * 128), (size_t)DM, SC_WO, tid, wid, lane); }
    }
}
constexpr int N_MOE_CONV = 32 * 16 * 16 + 32 * 16 * 8;
struct MoeItem { const float* W; int ldw, k0, srccol; unsigned char* dst; size_t pitch; float scale; int hi_extra; };
__device__ __forceinline__ MoeItem moe_item(const Args& a, int r, int lane) {
    constexpr int I_GU = 32 * 16 * 16; MoeItem it;
    const bool gu = r < I_GU; const int rd = gu ? 0 : r - I_GU;
    const int e = gu ? (r >> 8) : (rd >> 7), kb = gu ? ((r >> 4) & 15) : ((rd >> 3) & 15), cp = (r >> 1) & 7, pass = r & 1, ct = rd & 7;
    it.W = gu ? a.in[11] + (size_t)e * DM * 2 * FF : a.in[13] + (size_t)e * FF * DM;
    it.ldw = gu ? 2 * FF : DM; it.k0 = kb * 128; it.srccol = (gu ? pass * FF + cp * 256 : ct * 256) + 4 * lane;
    it.dst = gu ? a.ws + WS_WGU8 + ((size_t)(e * 4096 + cp * 512 + pass * 128) * DM + kb * 128) : a.ws + WS_WD8 + ((size_t)(e * 2048 + ct * 256) * FF + kb * 128);
    it.pitch = DM; it.scale = gu ? SC_WGU : SC_WD; it.hi_extra = gu ? 128 : 0;
    return it;
}
template <int NP>
__device__ __forceinline__ void moe_conv_group(const Args& a, unsigned char* img, int first, int limit, int tid, int wid, int lane) {
    (void)limit;
    f32x4 v0[16], v1[16], v2[16];
    { const MoeItem it = moe_item(a, first, lane); conv_load<true, true>(v0, it.W, it.ldw, it.k0, it.srccol, wid); }
    { const MoeItem it = moe_item(a, first + 1, lane); conv_load<true, true>(v1, it.W, it.ldw, it.k0, it.srccol, wid); }
    { const MoeItem it = moe_item(a, first + 2, lane); conv_load<true, true>(v2, it.W, it.ldw, it.k0, it.srccol, wid); }
#pragma unroll
    for (int p = 0; p < NP; ++p) {
        { const MoeItem it = moe_item(a, first + 3 * p, lane); conv_store<true>(v0, img, it.dst, it.pitch, it.scale, tid, wid, lane, it.hi_extra); }
        if (p + 1 < NP) { const MoeItem it = moe_item(a, first + 3 * p + 3, lane); conv_load<true, true>(v0, it.W, it.ldw, it.k0, it.srccol, wid); }
        { const MoeItem it = moe_item(a, first + 3 * p + 1, lane); conv_store<true>(v1, img, it.dst, it.pitch, it.scale, tid, wid, lane, it.hi_extra); }
        if (p + 1 < NP) { const MoeItem it = moe_item(a, first + 3 * p + 4, lane); conv_load<true, true>(v1, it.W, it.ldw, it.k0, it.srccol, wid); }
        { const MoeItem it = moe_item(a, first + 3 * p + 2, lane); conv_store<true>(v2, img, it.dst, it.pitch, it.scale, tid, wid, lane, it.hi_extra); }
        if (p + 1 < NP) { const MoeItem it = moe_item(a, first + 3 * p + 5, lane); conv_load<true, true>(v2, it.W, it.ldw, it.k0, it.srccol, wid); }
    }
}
typedef short v4i16_t __attribute__((ext_vector_type(4)));
constexpr float LOG2E = 1.4426950408889634f;
constexpr float NEGBIG = -1.0e30f;
constexpr int ATT_STAGE = 34816, ATT_NST = 3;
constexpr int ATT_KO = 0, ATT_VO = 16384, ATT_CO = 32768, ATT_Q = ATT_STAGE * ATT_NST;

template <bool FOX>
__device__ __forceinline__ void attn_unit(const Args& a, unsigned char* lds, int b, int h, int dil, int res, int qblk, int pat, int tid, int wid, int lane_in) {
    const bf16_t* QKV = (const bf16_t*)(a.ws + WS_QKV);
    int lane = lane_in; asm volatile("" : "+v"(lane));
    const int fr = lane & 15, fq = lane >> 4;
    const size_t rowb = (size_t)b * SEQ;
    const bf16_t* qsec = QKV + (FOX ? 3072 : 0) + h * HD;
    const char* ksec = (const char*)(QKV + (FOX ? 4096 : 1024) + h * HD);
    const char* vsec = (const char*)(QKV + (FOX ? 5120 : 2048) + h * HD);
    const float* cum = (const float*)(a.ws + WS_CUM) + (b * 8 + h) * SEQ;
    const int i0 = qblk * 256, iq0 = i0 + 32 * wid;
    const int kt_lo = FOX ? 0 : max(0, 4 * qblk - 2), kt_hi = 4 * qblk + 3;
    LAS unsigned char* ldsl = (LAS unsigned char*)lds;
    bf16x8 qf[2][4];
#pragma unroll
    for (int qb = 0; qb < 2; ++qb) {
        const bf16_t* qp = qsec + (rowb + res + (size_t)dil * (iq0 + 16 * qb + fr)) * QKVW + 8 * fq;
#pragma unroll
        for (int s = 0; s < 4; ++s) qf[qb][s] = *(const bf16x8*)(qp + 32 * s);
    }
    float cq[2] = {0.f, 0.f};
    if (FOX) { cq[0] = cum[iq0 + fr]; cq[1] = cum[iq0 + 16 + fr]; }
    const float slope2 = exp2f(-(float)(h + 1)) * (float)dil * LOG2E;
    bool inited[2] = {false, false};
    float mrun[2] = {0.f, 0.f}, lrun[2] = {0.f, 0.f};
    f32x4 ot[2][8];
#pragma unroll
    for (int qb = 0; qb < 2; ++qb)
#pragma unroll
        for (int dt = 0; dt < 8; ++dt) ot[qb][dt] = (f32x4){0.f, 0.f, 0.f, 0.f};
#define ATT_ROW(i) (4 * (wid + 8 * (i)) + (lane >> 4))
#define ATT_KOFF(i) ((unsigned)((size_t)dil * ATT_ROW(i) * QKVW * 2 + (((lane & 15) ^ (ATT_ROW(i) & 15)) << 4)))
#define ATT_VOFF(i) ((unsigned)((size_t)dil * ATT_ROW(i) * QKVW * 2 + (((lane & 15) ^ (2 * (ATT_ROW(i) & 7))) << 4)))
    const size_t tile_bytes = (size_t)dil * 64 * QKVW * 2;
    const char* kbase = ksec + (rowb + res) * (size_t)QKVW * 2;
    const char* vbase = vsec + (rowb + res) * (size_t)QKVW * 2;
#define ATT_STAGE_TILE(st, kt) do { const size_t tb_ = (size_t)(kt) * tile_bytes; _Pragma("unroll") for (int i = 0; i < 2; ++i) { \
        __builtin_amdgcn_global_load_lds((const unsigned*)(kbase + tb_ + ATT_KOFF(i)), (LAS unsigned*)(ldsl + (st) * ATT_STAGE + ATT_KO + (wid + 8 * i) * 1024), 16, 0, 0); \
        __builtin_amdgcn_global_load_lds((const unsigned*)(vbase + tb_ + ATT_VOFF(i)), (LAS unsigned*)(ldsl + (st) * ATT_STAGE + ATT_VO + (wid + 8 * i) * 1024), 16, 0, 0); } \
        if (FOX) __builtin_amdgcn_global_load_lds((const unsigned*)(cum + (kt) * 64 + lane), (LAS unsigned*)(ldsl + (st) * ATT_STAGE + ATT_CO + wid * 256), 4, 0, 0); } while (0)
    const int tq = fr >> 2, tp = fr & 3, r7 = (4 * (fq & 1) + tq) & 7;
    const int trbase = ATT_VO + (4 * fq + tq) * 256 + (tp >> 1) * 16 + (tp & 1) * 8;
    int st_cur = 0;
    ATT_STAGE_TILE(0, kt_lo);
    ATT_STAGE_TILE(1, (kt_lo + 1 <= kt_hi) ? kt_lo + 1 : kt_hi);
    for (int kt = kt_lo; kt <= kt_hi; ++kt) {
        if (FOX) asm volatile("s_waitcnt vmcnt(5) lgkmcnt(0)" ::: "memory"); else asm volatile("s_waitcnt vmcnt(4) lgkmcnt(0)" ::: "memory");
        __builtin_amdgcn_s_barrier();
        asm volatile("" ::: "memory");
        { const int st_n = (st_cur >= 1) ? st_cur - 1 : 2; const int ktn = (kt + 2 <= kt_hi) ? kt + 2 : kt_hi; ATT_STAGE_TILE(st_n, ktn); }
        const int sb = st_cur * ATT_STAGE;
        const int k0 = kt * 64;
        const bool active = FOX ? (k0 <= iq0 + 31) : ((k0 <= iq0 + 31) && (k0 + 63 >= iq0 - 128));
        if (active) {
            const bool boundary = FOX ? (k0 + 63 > iq0) : !((iq0 + 31 - k0 <= 128) && (iq0 - (k0 + 63) >= 0));
            f32x4 st[2][4];
            if (boundary) {
#pragma unroll
                for (int qb = 0; qb < 2; ++qb) {
                    const int iq = iq0 + 16 * qb + fr;
                    const float c0 = FOX ? (cq[qb] - mrun[qb]) : (-slope2 * (float)(iq - k0 - 4 * fq) - mrun[qb]);
#pragma unroll
                    for (int sub = 0; sub < 4; ++sub) {
                        f32x4 ck = {0.f, 0.f, 0.f, 0.f};
                        if (FOX) ck = *(const LAS f32x4*)(ldsl + sb + ATT_CO + wid * 256 + (16 * sub + 4 * fq) * 4);
#pragma unroll
                        for (int j = 0; j < 4; ++j) {
                            const float bv = FOX ? (c0 - ck[j]) : (c0 + slope2 * (float)(16 * sub + j));
                            const int delta = iq - (k0 + 16 * sub + 4 * fq + j);
                            const bool valid = FOX ? (delta >= 0) : ((unsigned)delta <= 128u);
                            st[qb][sub][j] = valid ? bv : NEGBIG;
                        }
                    }
                }
            } else {
#pragma unroll
                for (int qb = 0; qb < 2; ++qb) {
                    const int iq = iq0 + 16 * qb + fr;
                    const float c0 = FOX ? (cq[qb] - mrun[qb]) : (-slope2 * (float)(iq - k0 - 4 * fq) - mrun[qb]);
#pragma unroll
                    for (int sub = 0; sub < 4; ++sub) {
                        f32x4 ck = {0.f, 0.f, 0.f, 0.f};
                        if (FOX) ck = *(const LAS f32x4*)(ldsl + sb + ATT_CO + wid * 256 + (16 * sub + 4 * fq) * 4);
#pragma unroll
                        for (int j = 0; j < 4; ++j) st[qb][sub][j] = FOX ? (c0 - ck[j]) : (c0 + slope2 * (float)(16 * sub + j));
                    }
                }
            }
            {
#ifndef KPF
#define KPF 2
#endif
                unsigned kad[4];
#pragma unroll
                for (int s = 0; s < 4; ++s) kad[s] = (unsigned)(sb + ATT_KO + fr * 256 + (((4 * s + fq) ^ fr) << 4));
                bf16x8 kr[KPF + 1];
#define ATT_KREAD(f) asm volatile("ds_read_b128 %0, %1 offset:%2" : "=&v"(kr[(f) % (KPF + 1)]) : "v"(kad[(f) & 3]), "i"(((f) >> 2) * 4096) : "memory")
#pragma unroll
                for (int f = 0; f < KPF; ++f) ATT_KREAD(f);
#pragma unroll
                for (int f = 0; f < 16; ++f) {
                    if (f + KPF < 16) ATT_KREAD(f + KPF);
                    const int pend = (15 - f) < KPF ? (15 - f) : KPF;
                    if (pend == 0) asm volatile("s_waitcnt lgkmcnt(0)" ::: "memory");
                    else if (pend == 1) asm volatile("s_waitcnt lgkmcnt(1)" ::: "memory");
                    else if (pend == 2) asm volatile("s_waitcnt lgkmcnt(2)" ::: "memory");
                    else if (pend == 3) asm volatile("s_waitcnt lgkmcnt(3)" ::: "memory");
                    else asm volatile("s_waitcnt lgkmcnt(4)" ::: "memory");
                    __builtin_amdgcn_sched_barrier(0);
                    const int sub = f >> 2, s = f & 3;
                    st[0][sub] = __builtin_amdgcn_mfma_f32_16x16x32_bf16(kr[f % (KPF + 1)], qf[0][s], st[0][sub], 0, 0, 0);
                    st[1][sub] = __builtin_amdgcn_mfma_f32_16x16x32_bf16(kr[f % (KPF + 1)], qf[1][s], st[1][sub], 0, 0, 0);
                }
#undef ATT_KREAD
            }
            float mloc[2];
#pragma unroll
            for (int qb = 0; qb < 2; ++qb) {
                float mx = NEGBIG;
#pragma unroll
                for (int sub = 0; sub < 4; ++sub)
#pragma unroll
                    for (int j = 0; j < 4; ++j) mx = fmaxf(mx, st[qb][sub][j]);
                mx = fmaxf(mx, __shfl_xor(mx, 16)); mx = fmaxf(mx, __shfl_xor(mx, 32));
                mloc[qb] = mx;
            }
            const bool need0 = (mloc[0] > -1.0e29f) && (!inited[0] || mloc[0] > 8.f), need1 = (mloc[1] > -1.0e29f) && (!inited[1] || mloc[1] > 8.f);
            if (__any(need0 || need1)) {
#pragma unroll
                for (int qb = 0; qb < 2; ++qb) {
                    const bool nd = (qb == 0) ? need0 : need1;
                    const float shift = nd ? mloc[qb] : 0.f;
                    const float alpha = (nd && inited[qb]) ? __builtin_amdgcn_exp2f(-shift) : 1.f;
                    mrun[qb] += shift; lrun[qb] *= alpha; inited[qb] = inited[qb] || nd;
#pragma unroll
                    for (int dt = 0; dt < 8; ++dt) ot[qb][dt] *= alpha;
#pragma unroll
                    for (int sub = 0; sub < 4; ++sub) st[qb][sub] -= shift;
                }
            }
            bf16x8 pb[2][2];
#pragma unroll
            for (int qb = 0; qb < 2; ++qb) {
                float psum = 0.f;
#pragma unroll
                for (int sub = 0; sub < 4; ++sub)
#pragma unroll
                    for (int j = 0; j < 4; ++j) { const float p = __builtin_amdgcn_exp2f(st[qb][sub][j]); st[qb][sub][j] = p; psum += p; }
                lrun[qb] += psum;
#pragma unroll
                for (int ks = 0; ks < 2; ++ks) {
                    u32x4 w;
                    w.x = cvtpk(st[qb][2 * ks][0], st[qb][2 * ks][1]); w.y = cvtpk(st[qb][2 * ks][2], st[qb][2 * ks][3]);
                    w.z = cvtpk(st[qb][2 * ks + 1][0], st[qb][2 * ks + 1][1]); w.w = cvtpk(st[qb][2 * ks + 1][2], st[qb][2 * ks + 1][3]);
                    pb[qb][ks] = __builtin_bit_cast(bf16x8, w);
                }
            }
            {
                v4i16_t lo[2][2][2], hi[2][2][2];
#define ATT_VREAD(buf, dp) do { _Pragma("unroll") for (int d2 = 0; d2 < 2; ++d2) { const unsigned dto = (unsigned)(sb + trbase + (((2 * (dp) + d2) ^ r7) << 5)); \
                    _Pragma("unroll") for (int ks = 0; ks < 2; ++ks) { \
                        asm volatile("ds_read_b64_tr_b16 %0, %1 offset:%2" : "=&v"(lo[buf][d2][ks]) : "v"(dto), "i"((32 * ks) * 256) : "memory"); \
                        asm volatile("ds_read_b64_tr_b16 %0, %1 offset:%2" : "=&v"(hi[buf][d2][ks]) : "v"(dto), "i"((32 * ks + 16) * 256) : "memory"); } } } while (0)
                ATT_VREAD(0, 0);
#pragma unroll
                for (int dp = 0; dp < 4; ++dp) {
                    if (dp < 3) { if ((dp & 1) == 0) ATT_VREAD(1, dp + 1); else ATT_VREAD(0, dp + 1); }
                    if (dp < 3) asm volatile("s_waitcnt lgkmcnt(8)" ::: "memory"); else asm volatile("s_waitcnt lgkmcnt(0)" ::: "memory");
                    __builtin_amdgcn_sched_barrier(0);
#pragma unroll
                    for (int d2 = 0; d2 < 2; ++d2)
#pragma unroll
                        for (int ks = 0; ks < 2; ++ks) {
                            const v4i16_t l = lo[dp & 1][d2][ks], h = hi[dp & 1][d2][ks];
                            const bf16x8 va = {l[0], l[1], l[2], l[3], h[0], h[1], h[2], h[3]};
                            ot[0][2 * dp + d2] = __builtin_amdgcn_mfma_f32_16x16x32_bf16(va, pb[0][ks], ot[0][2 * dp + d2], 0, 0, 0);
                            ot[1][2 * dp + d2] = __builtin_amdgcn_mfma_f32_16x16x32_bf16(va, pb[1][ks], ot[1][2 * dp + d2], 0, 0, 0);
                        }
                    __builtin_amdgcn_sched_barrier(0);
                }
#undef ATT_VREAD
            }
        }
        st_cur = (st_cur == 2) ? 0 : st_cur + 1;
    }
#undef ATT_STAGE_TILE
#undef ATT_ROW
#undef ATT_KOFF
#undef ATT_VOFF
    asm volatile("s_waitcnt vmcnt(0) lgkmcnt(0)" ::: "memory");
    __builtin_amdgcn_s_barrier();
#pragma unroll
    for (int qb = 0; qb < 2; ++qb) {
        float lt = lrun[qb]; lt += __shfl_xor(lt, 16); lt += __shfl_xor(lt, 32);
        const float inv = 1.f / lt;
        const size_t row = rowb + res + (size_t)dil * (iq0 + 16 * qb + fr);
        bf16_t* op = FOX ? ((bf16_t*)(a.ws + WS_MIX) + row * DM + 1024 + h * HD + 4 * fq)
                         : ((bf16_t*)(a.ws + WS_PART) + ((size_t)pat * NTOK + row) * 1024 + h * HD + 4 * fq);
#pragma unroll
        for (int dt = 0; dt < 8; ++dt) {
            const f32x4 v = ot[qb][dt] * inv; u32x2 w; w.x = cvtpk(v.x, v.y); w.y = cvtpk(v.z, v.w);
            *(u32x2*)(op + 16 * dt) = w;
        }
        if (!FOX && fq == 0) ((float*)(a.ws + WS_LSE))[((size_t)pat * NTOK + row) * 8 + h] = mrun[qb] + __builtin_amdgcn_logf(lt);
    }
}

__device__ __forceinline__ void conv_one(const Args& a, unsigned char* img, int r, int tid, int wid, int lane) {
    const MoeItem it = moe_item(a, r, lane); f32x4 v[16];
    conv_load<true, true>(v, it.W, it.ldw, it.k0, it.srccol, wid);
    conv_store<true>(v, img, it.dst, it.pitch, it.scale, tid, wid, lane, it.hi_extra);
}
constexpr int CW_BWQ = CW_ATTQ + 256;
#ifndef BW_CAP_N
#define BW_CAP_N 4096
#endif
constexpr int BW_CAP = BW_CAP_N;
__device__ __forceinline__ void xcd_barrier_conv(const XcdBarrier& b, const Args& a, unsigned char* lds, int tid, int wid, int lane) {
    volatile int* sw = (volatile int*)(lds + 147328);
    unsigned* QB = (unsigned*)(a.ws + WS_CTL) + CW_BWQ;
    asm volatile("s_waitcnt vmcnt(0)" ::: "memory");
    __syncthreads();
    if (threadIdx.x == 0) {
        unsigned* bar = b.bar;
        __builtin_amdgcn_s_waitcnt(0);
        unsigned nloc = b.st[0], nx = b.st[1];
        if (nloc == 0u) { xcd_barrier_complete(bar, b.x, nloc, nx); b.st[0] = nloc; b.st[1] = nx; }
        const unsigned old = xb_add(&bar[XB_XSUB(b.x)], 1u);
        const unsigned gen = old / nloc;
        if (old + 1u == (gen + 1u) * nloc) {
            __builtin_amdgcn_fence(__ATOMIC_RELEASE, "agent");
            asm volatile("s_waitcnt vmcnt(0)" ::: "memory");
            const unsigned og = xb_add(&bar[XB_TOP], 1u);
            const unsigned tg = og / nx;
            if (og + 1u == (tg + 1u) * nx) xb_add(&bar[XB_TOPGEN], 1u);
            else XB_SPIN(xb_ld(&bar[XB_TOPGEN]) == tg, bar);
            __builtin_amdgcn_fence(__ATOMIC_ACQUIRE, "agent");
            xb_add(&bar[XB_XGEN(b.x)], 1u);
            asm volatile("s_waitcnt vmcnt(0)" ::: "memory");
            sw[0] = 1;
        } else { sw[0] = 0; sw[1] = (int)gen; }
    }
    __syncthreads();
    if (sw[0] == 0) {
        const unsigned gen = (unsigned)sw[1];
        for (;;) {
            if (threadIdx.x == 0) {
                int rel = (xb_ld(&b.bar[XB_XGEN(b.x)]) != gen) ? 1 : 0, item = -1;
                if (!rel) {
                    const unsigned t = xb_add(QB, 1u);
                    if (t < (unsigned)BW_CAP) item = N_MOE_CONV - 1 - (int)t;
                    else { XB_SPIN(xb_ld(&b.bar[XB_XGEN(b.x)]) == gen, b.bar); rel = 1; }
                }
                sw[2] = rel; sw[3] = item;
            }
            __syncthreads();
            const int rel = sw[2], item = sw[3];
            if (rel) break;
            conv_one(a, lds + 65536, item, tid, wid, lane);
        }
        if (threadIdx.x == 0) { __builtin_amdgcn_fence(__ATOMIC_ACQUIRE, "agent"); asm volatile("s_waitcnt vmcnt(0)" ::: "memory"); }
        __syncthreads();
    }
}
__device__ __forceinline__ void phase_attn(const Args& a, unsigned char* lds, int tid, int wid, int lane, int rep) {
    unsigned* QA = (unsigned*)(a.ws + WS_CTL) + CW_ATTQ + 64 * rep;
    unsigned* QC = (unsigned*)(a.ws + WS_CTL) + CW_ATTQ + 128 + 64 * rep;
    volatile int* qw = (volatile int*)(lds + ATT_Q);
    constexpr int limit = N_MOE_CONV - BW_CAP;
    constexpr int NCG = (limit + 5) / 6;
    const bool pref_conv = (blockIdx.x % 5) < 3;
    bool a_done = false, c_done = (rep != 0);
    for (;;) {
        __syncthreads();
        if (tid == 0) {
            int kind = -1, idx = 0;
#pragma unroll
            for (int pass = 0; pass < 2; ++pass) {
                const bool try_conv = (pass == 0) ? pref_conv : !pref_conv;
                if (kind < 0) {
                    if (try_conv) { if (!c_done) { idx = (int)__hip_atomic_fetch_add(QC, 1u, __ATOMIC_RELAXED, __HIP_MEMORY_SCOPE_AGENT); if (idx < NCG) kind = 1; else c_done = true; } }
                    else { if (!a_done) { idx = (int)__hip_atomic_fetch_add(QA, 1u, __ATOMIC_RELAXED, __HIP_MEMORY_SCOPE_AGENT); if (idx < 1024) kind = 0; else a_done = true; } }
                }
            }
            qw[0] = kind; qw[1] = idx;
        }
        __syncthreads();
        const int kind = __builtin_amdgcn_readfirstlane(qw[0]), u = __builtin_amdgcn_readfirstlane(qw[1]);
        if (kind < 0) break;
        if (kind == 1) {
            moe_conv_group<2>(a, lds + 65536, u * 6, limit, tid, wid, lane);
            continue;
        }
        if (u < 256) { const int bh = u & 15; attn_unit<true>(a, lds, bh >> 3, bh & 7, 1, 0, 15 - (u >> 4), 0, tid, wid, lane); }
        else {
            const int up = u - 256, pat = up >> 8, v = up & 255, bh = v & 15, sub = v >> 4;
            const int dil = (pat == 0) ? 1 : (pat == 1 ? 4 : 16);
            const int res = (pat == 0) ? 0 : (pat == 1 ? (sub & 3) : sub);
            const int qblk = (pat == 0) ? sub : (pat == 1 ? (sub >> 2) : 0);
            attn_unit<false>(a, lds, bh >> 3, bh & 7, dil, res, qblk, pat, tid, wid, lane);
        }
    }
}

__device__ __forceinline__ void phase_combine(const Args& a, int wid, int lane) {
    const bf16_t* PART = (const bf16_t*)(a.ws + WS_PART); const float* LSE = (const float*)(a.ws + WS_LSE); const bf16_t* MIX = (const bf16_t*)(a.ws + WS_MIX);
    unsigned char* MIX8 = a.ws + WS_MIX8; float* MSC = (float*)(a.ws + WS_MSC);
    const int h = lane >> 3, c = (lane & 7) * 16;
    for (int row = blockIdx.x * 8 + wid; row < NTOK; row += gridDim.x * 8) {
        float l0 = LSE[(size_t)row * 8 + h], l1 = LSE[((size_t)NTOK + row) * 8 + h], l2 = LSE[((size_t)2 * NTOK + row) * 8 + h];
        const float mx = fmaxf(l0, fmaxf(l1, l2));
        float w0 = __builtin_amdgcn_exp2f(l0 - mx), w1 = __builtin_amdgcn_exp2f(l1 - mx), w2 = __builtin_amdgcn_exp2f(l2 - mx);
        const float inv = 1.f / (w0 + w1 + w2); w0 *= inv; w1 *= inv; w2 *= inv;
        float d[16], f[16]; float am = 0.f;
#pragma unroll
        for (int half = 0; half < 2; ++half) {
            const size_t off = (size_t)row * 1024 + h * HD + c + half * 8;
            const u32x4 p0 = *(const u32x4*)(PART + off), p1 = *(const u32x4*)(PART + (size_t)NTOK * 1024 + off), p2 = *(const u32x4*)(PART + (size_t)2 * NTOK * 1024 + off);
            const u32x4 fx = *(const u32x4*)(MIX + (size_t)row * DM + 1024 + 16 * lane + half * 8);
#pragma unroll
            for (int q = 0; q < 4; ++q) {
                d[half * 8 + 2 * q] = w0 * __uint_as_float(p0[q] << 16) + w1 * __uint_as_float(p1[q] << 16) + w2 * __uint_as_float(p2[q] << 16);
                d[half * 8 + 2 * q + 1] = w0 * __uint_as_float(p0[q] & 0xffff0000u) + w1 * __uint_as_float(p1[q] & 0xffff0000u) + w2 * __uint_as_float(p2[q] & 0xffff0000u);
                f[half * 8 + 2 * q] = __uint_as_float(fx[q] << 16); f[half * 8 + 2 * q + 1] = __uint_as_float(fx[q] & 0xffff0000u);
            }
        }
#pragma unroll
        for (int q = 0; q < 16; ++q) am = fmaxf(am, fmaxf(fabsf(d[q]), fabsf(f[q])));
        am = fmaxf(wave_max(am), 1e-20f);
        const float qs = 127.f / am; if (lane == 0) MSC[row] = am * (1.f / 127.f);
        u32x4 od, of;
#pragma unroll
        for (int q = 0; q < 4; ++q) { od[q] = pack_i8x4s(d[4 * q], d[4 * q + 1], d[4 * q + 2], d[4 * q + 3], qs); of[q] = pack_i8x4s(f[4 * q], f[4 * q + 1], f[4 * q + 2], f[4 * q + 3], qs); }
        *(u32x4*)(MIX8 + (size_t)row * DM + h * HD + c) = od;
        *(u32x4*)(MIX8 + (size_t)row * DM + 1024 + 16 * lane) = of;
    }
}

__device__ __forceinline__ void phase_ln1_router(const Args& a, unsigned char* lds, int tid, int wid, int lane) {
    constexpr int HP = 2050;
    float* hsa = (float*)lds;
    float* hs = hsa + (wid * 2) * HP;
    float* red = (float*)lds;
    float* lg = (float*)(lds + 132096);
    int* hist = (int*)(lds + 132096 + 2048);
    int* base = hist + 32;
    const bf16_t* Y = (const bf16_t*)(a.ws + WS_Y); bf16_t* X1 = (bf16_t*)(a.ws + WS_X1); unsigned char* XS = a.ws + WS_XS;
    const float* mod = (const float*)(a.ws + WS_MOD);
    const float* g1 = a.in[7]; const float* b1 = a.in[8]; const float* wrt = a.in[9]; const float* brt = a.in[10];
    int* TOPI = (int*)(a.ws + WS_TOPI); float* GATE = (float*)(a.ws + WS_GATE); int* LIST = (int*)(a.ws + WS_LIST);
    unsigned* CNT = (unsigned*)(a.ws + WS_CTL) + CW_CNT;
    for (int rb = blockIdx.x; rb < 512; rb += gridDim.x) {
        const int row0 = rb * 16 + wid * 2, b = row0 >> 12;
        const float* shm = mod + b * 12288 + 3 * 2048; const float* scm = mod + b * 12288 + 4 * 2048;
        unsigned hq[2][8]; float hsc[2];
        {
            f32x4 v[2][8]; float rstd[2];
#pragma unroll
            for (int r = 0; r < 2; ++r)
#pragma unroll
                for (int i = 0; i < 8; ++i) { const u32x2 yw = *(const u32x2*)(Y + (size_t)(row0 + r) * DM + 4 * lane + 256 * i);
                    v[r][i] = (f32x4){__uint_as_float(yw.x << 16), __uint_as_float(yw.x & 0xffff0000u), __uint_as_float(yw.y << 16), __uint_as_float(yw.y & 0xffff0000u)}; }
#pragma unroll
            for (int r = 0; r < 2; ++r) {
                float s = 0.f;
#pragma unroll
                for (int i = 0; i < 8; ++i) s += (v[r][i].x + v[r][i].y) + (v[r][i].z + v[r][i].w);
                const float mean = wave_sum(s) * (1.f / DM); float q = 0.f;
#pragma unroll
                for (int i = 0; i < 8; ++i) { v[r][i] -= mean; q += (v[r][i].x * v[r][i].x + v[r][i].y * v[r][i].y) + (v[r][i].z * v[r][i].z + v[r][i].w * v[r][i].w); }
                rstd[r] = 1.f / sqrtf(wave_sum(q) * (1.f / DM) + LN_EPS);
            }
#pragma unroll
            for (int ib = 0; ib < 8; ib += 4) {
                f32x4 pg[4], pb[4], psc[4], psh[4];
#pragma unroll
                for (int j = 0; j < 4; ++j) { const int k0 = 4 * lane + 256 * (ib + j); pg[j] = *(const f32x4*)(g1 + k0); pb[j] = *(const f32x4*)(b1 + k0); psc[j] = *(const f32x4*)(scm + k0); psh[j] = *(const f32x4*)(shm + k0); }
#pragma unroll
                for (int j = 0; j < 4; ++j) {
                    const int i = ib + j, k0 = 4 * lane + 256 * i;
#pragma unroll
                    for (int r = 0; r < 2; ++r) {
                        const f32x4 x1 = v[r][i] * rstd[r] * pg[j] + pb[j];
                        { u32x2 xw; xw.x = cvtpk(x1.x, x1.y); xw.y = cvtpk(x1.z, x1.w); *(u32x2*)(X1 + (size_t)(row0 + r) * DM + k0) = xw; }
                        const f32x4 h2 = x1 * (psc[j] + 1.f) + psh[j];
                        v[r][i] = h2;
                        *(f32x2*)(hs + r * HP + k0) = (f32x2){h2.x, h2.y}; *(f32x2*)(hs + r * HP + k0 + 2) = (f32x2){h2.z, h2.w};
                    }
                }
            }
#pragma unroll
            for (int r = 0; r < 2; ++r) {
                float am = 0.f;
#pragma unroll
                for (int i = 0; i < 8; ++i) am = fmaxf(am, fmaxf(fmaxf(fabsf(v[r][i].x), fabsf(v[r][i].y)), fmaxf(fabsf(v[r][i].z), fabsf(v[r][i].w))));
                am = fmaxf(wave_max(am), 1e-20f);
                const float qs = 127.f / am; hsc[r] = am * (1.f / 127.f);
#pragma unroll
                for (int i = 0; i < 8; ++i) hq[r][i] = pack_i8x4s(v[r][i].x, v[r][i].y, v[r][i].z, v[r][i].w, qs);
            }
        }
        __syncthreads();
        {
            f32x4 c0 = {0.f, 0.f, 0.f, 0.f}, c1 = {0.f, 0.f, 0.f, 0.f};
            const int fr = lane & 15, fq = lane >> 4;
            const float* ap = hsa + fr * HP + 256 * wid + fq;
            const float* bp = wrt + (size_t)(256 * wid + fq) * NE + 2 * fr;
#pragma unroll 16
            for (int st = 0; st < 64; ++st) {
                const float av = ap[4 * st];
                const f32x2 bb = *(const f32x2*)(bp + (size_t)(4 * st) * NE);
                c0 = __builtin_amdgcn_mfma_f32_16x16x4f32(av, bb.x, c0, 0, 0, 0);
                c1 = __builtin_amdgcn_mfma_f32_16x16x4f32(av, bb.y, c1, 0, 0, 0);
            }
            __syncthreads();
#pragma unroll
            for (int j = 0; j < 4; ++j) *(f32x2*)(red + (wid * 16 + 4 * fq + j) * 32 + 2 * fr) = (f32x2){c0[j], c1[j]};
            __syncthreads();
            { const int tk = tid >> 5, e = tid & 31; float sum = brt[e];
#pragma unroll
              for (int w = 0; w < 8; ++w) sum += red[(w * 16 + tk) * 32 + e];
              lg[tk * 32 + e] = sum; }
        }
        if (tid < 32) hist[tid] = 0;
        __syncthreads();
        int esel[4], rank[4];
#pragma unroll
        for (int s = 0; s < 4; ++s) { esel[s] = 0; rank[s] = 0; }
        const int tok = row0 + lane;
        float tv[4];
        {
            float lv = lg[(wid * 2 + (lane >> 5)) * 32 + (lane & 31)];
#pragma unroll
            for (int s = 0; s < 4; ++s) {
                float best = lv;
#pragma unroll
                for (int o = 1; o < 32; o <<= 1) best = fmaxf(best, __shfl_xor(best, o));
                const unsigned long long bm = __ballot(lv == best);
                const int bi = __builtin_ctz((unsigned)(bm >> (lane & 32)));
                if ((lane & 31) == bi) lv = -3.0e38f;
                tv[s] = __shfl(best, (lane & 1) * 32); esel[s] = __shfl(bi, (lane & 1) * 32);
            }
        }
        if (lane < 2) {
            const float e0 = 1.f, e1 = expf(tv[1] - tv[0]), e2 = expf(tv[2] - tv[0]), e3 = expf(tv[3] - tv[0]);
            const float inv = 1.f / (e0 + e1 + e2 + e3);
            GATE[tok * 4 + 0] = e0 * inv; GATE[tok * 4 + 1] = e1 * inv; GATE[tok * 4 + 2] = e2 * inv; GATE[tok * 4 + 3] = e3 * inv;
#pragma unroll
            for (int s = 0; s < 4; ++s) { TOPI[tok * 4 + s] = esel[s]; rank[s] = atomicAdd(&hist[esel[s]], 1); }
        }
        __syncthreads();
        if (tid < 32) base[tid] = (int)__hip_atomic_fetch_add(&CNT[tid], (unsigned)hist[tid], __ATOMIC_RELAXED, __HIP_MEMORY_SCOPE_AGENT);
        __syncthreads();
        int pos[4];
#pragma unroll
        for (int s = 0; s < 4; ++s) pos[s] = 0;
        if (lane < 2) {
#pragma unroll
            for (int s = 0; s < 4; ++s) { pos[s] = base[esel[s]] + rank[s]; LIST[esel[s] * NTOK + pos[s]] = tok * 4 + s; }
        }
#pragma unroll
        for (int r = 0; r < 2; ++r)
#pragma unroll
            for (int s = 0; s < 4; ++s) {
                const int e = __shfl(esel[s], r), p = __shfl(pos[s], r);
                unsigned char* dstp = XS + ((size_t)e * NTOK + p) * DM + 4 * lane;
#pragma unroll
                for (int i = 0; i < 8; ++i) *(unsigned*)(dstp + 256 * i) = hq[r][i];
                if (lane == 0) ((float*)(a.ws + WS_XSC))[(size_t)e * NTOK + p] = hsc[r];
            }
        __syncthreads();
    }
}

__device__ __forceinline__ void phase_final(const Args& a, int wid, int lane, const f32x4 (&pg)[8], const f32x4 (&pb)[8]) {
    const bf16_t* X1 = (const bf16_t*)(a.ws + WS_X1); const unsigned char* Y2 = a.ws + WS_Y2; const float* mod = (const float*)(a.ws + WS_MOD);
    const float* g2 = a.in[15]; const float* b2 = a.in[16];
    for (int row = blockIdx.x * 8 + wid; row < NTOK; row += gridDim.x * 8) {
        const int b = row >> 12; const float* gm = mod + b * 12288 + 5 * 2048;
        f32x4 v[8]; float s = 0.f;
#pragma unroll
        for (int i = 0; i < 8; ++i) {
            const int k0 = 4 * lane + 256 * i;
            f32x4 f = {0.f, 0.f, 0.f, 0.f};
#pragma unroll
            for (int sl = 0; sl < 4; ++sl) {
                const int w = (int)__builtin_nontemporal_load((const unsigned*)(Y2 + (size_t)(row * 4 + sl) * DM + k0));
                const f32x2 lo = __builtin_amdgcn_cvt_pk_f32_fp8(w, false), hi = __builtin_amdgcn_cvt_pk_f32_fp8(w, true);
                f.x += lo[0]; f.y += lo[1]; f.z += hi[0]; f.w += hi[1];
            }
            const u32x2 xw = *(const u32x2*)(X1 + (size_t)row * DM + k0);
            const f32x4 x1v = {__uint_as_float(xw.x << 16), __uint_as_float(xw.x & 0xffff0000u), __uint_as_float(xw.y << 16), __uint_as_float(xw.y & 0xffff0000u)};
            v[i] = ALPHA * x1v + *(const f32x4*)(gm + k0) * f;
            s += (v[i].x + v[i].y) + (v[i].z + v[i].w);
        }
        const float mean = wave_sum(s) * (1.f / DM); float q = 0.f;
#pragma unroll
        for (int i = 0; i < 8; ++i) { v[i] -= mean; q += (v[i].x * v[i].x + v[i].y * v[i].y) + (v[i].z * v[i].z + v[i].w * v[i].w); }
        const float rstd = 1.f / sqrtf(wave_sum(q) * (1.f / DM) + LN_EPS);
#pragma unroll
        for (int i = 0; i < 8; ++i) {
            const int k0 = 4 * lane + 256 * i;
            __builtin_nontemporal_store(v[i] * rstd * pg[i] + pb[i], (f32x4*)(a.out + (size_t)row * DM + k0));
        }
    }
}

__global__ void __launch_bounds__(512, 2) fwd_kernel(Args a) {
    extern __shared__ __attribute__((aligned(16))) unsigned char lds[];
    const int tid = threadIdx.x, lane = tid & 63, wid = __builtin_amdgcn_readfirstlane(tid >> 6);
    const int G = gridDim.x, bx = blockIdx.x;
    const int vcu = (G % 8 == 0) ? (bx % 8) * (G / 8) + bx / 8 : bx;
    if (tid < 4) ((unsigned*)(lds + LDS_BARW))[tid] = 0u;
    __syncthreads();
    unsigned* ctl = (unsigned*)(a.ws + WS_CTL);
    XcdBarrier bar; bar.bar = ctl + CW_BAR; bar.x = 0; bar.st = nullptr;
    if (N_LAUNCH == 1) bar = xcd_barrier_post(ctl + CW_BAR, (volatile LAS unsigned*)(lds + LDS_BARW));
    const int lo = a.ph_lo, hi = a.ph_hi;
#ifndef PHASE_MASK
#define PHASE_MASK 0x3ff
#endif
#define IN(k) (((PHASE_MASK >> (k)) & 1) && lo <= (k) && (k) < hi)
#define SEAM(k) do { if (IN(k) && IN((k) + 1)) xcd_barrier(bar); } while (0)
#ifndef BW_MASK
#define BW_MASK 0x7f
#endif
#define SEAMW(k) do { if (IN(k) && IN((k) + 1)) { if ((BW_MASK >> (k)) & 1) xcd_barrier_conv(bar, a, lds, tid, wid, lane); else xcd_barrier(bar); } } while (0)
#ifndef REPEAT_MASK
#define REPEAT_MASK 0
#endif
#define RF(k) ((((REPEAT_MASK) >> (k)) & 1) + 1)
#define REP(k) _Pragma("unroll 1") for (int rep_ = 0; rep_ < (((REPEAT_MASK) >> (k)) & 1) + 1; ++rep_)

    LAS unsigned char* ldsl = (LAS unsigned char*)lds;
    if (IN(0)) { phase_ada(a, lds, tid); for (int rp = 0; rp < RF(0); ++rp) phase_convert_dense(a, lds, tid, wid, lane); if (RF(10) > 1) phase_ada(a, lds, tid); }
    if (IN(1)) phase_mod1_stage(a, lds, tid);
    SEAMW(0);
    if (IN(1)) { for (int rp = 0; rp < RF(1); ++rp) phase_mod1(a, lds, tid, wid, lane); } SEAMW(1);
    if (IN(2)) {
        phase_cumsum(a, lds, tid, wid, lane);
        __syncthreads();
        const pg8::Gemm g{(const bf16_t*)(a.ws + WS_HA), (const bf16_t*)(a.ws + WS_WINT), DM / 2};
        const SchedDense S{24, G, vcu, RF(2)}; const EpiQKV E{(bf16_t*)(a.ws + WS_QKV), (const float*)(a.ws + WS_HSC)};
        pg8::gemm_phase<true, EpiQKV, SchedDense, true>(ldsl, g, S, E);
        __syncthreads();
    } SEAMW(2);
    if (IN(3)) { phase_attn(a, lds, tid, wid, lane, 0); if (RF(3) > 1) { xcd_barrier(bar); phase_attn(a, lds, tid, wid, lane, 1); } } SEAMW(3);
    if (IN(4)) { for (int rp = 0; rp < RF(4); ++rp) phase_combine(a, wid, lane); } SEAMW(4);
    if (IN(5)) {
        const pg8::Gemm g{(const bf16_t*)(a.ws + WS_MIX8), (const bf16_t*)(a.ws + WS_WOUTT), DM / 2};
        const SchedDense S{8, G, vcu, RF(5)}; const EpiOut E{(bf16_t*)(a.ws + WS_Y), a.in[0], (const float*)(a.ws + WS_MOD), (const float*)(a.ws + WS_MSC)};
        pg8::gemm_phase<true, EpiOut, SchedDense, false>(ldsl, g, S, E);
        __syncthreads();
    } SEAMW(5);
    if (IN(6)) { phase_ln1_router(a, lds, tid, wid, lane); } SEAMW(6);
    if (IN(7) || IN(8)) {
        int* tb = (int*)(lds + 140000);
        int* cn = tb + 40;
        const unsigned* CNT = ctl + CW_CNT;
        __syncthreads();
        if (tid == 0) { int acc = 0, ah = 0, al = 0; for (int e = 0; e < NE; ++e) { const int c = (int)CNT[e], nt_e = (c + 255) >> 8, lt = (nt_e > 0 && c - (nt_e - 1) * 256 <= 128) ? 1 : 0;
                cn[e] = c; tb[e] = acc; tb[160 + e] = ah; tb[200 + e] = al; acc += nt_e; ah += nt_e - lt; al += lt; } tb[NE] = acc; tb[160 + NE] = ah; tb[200 + NE] = al; }
        __syncthreads();
        if (IN(7)) {
            const pg8::Gemm g{(const bf16_t*)(a.ws + WS_XS), (const bf16_t*)(a.ws + WS_WGU8), DM / 2};
            const int nu = build_moe_list(tb + 80, tb, cn, 16, G, vcu, RF(7), tid);
            const SchedList S{tb + 80, nu}; const EpiGlu E{a.ws + WS_ACT, a.in[12], cn, (const float*)(a.ws + WS_XSC)};
            pg8::gemm_phase<true, EpiGlu, SchedList, true>(ldsl, g, S, E);
            __syncthreads();
            {
                volatile int* sw = (volatile int*)(lds + 147328);
                unsigned* QB = ctl + CW_BWQ;
                for (;;) {
                    if (tid == 0) { const unsigned t = __hip_atomic_fetch_add(QB, 1u, __ATOMIC_RELAXED, __HIP_MEMORY_SCOPE_AGENT); sw[3] = (t < (unsigned)BW_CAP) ? N_MOE_CONV - 1 - (int)t : -1; }
                    __syncthreads();
                    const int item = sw[3];
                    if (item < 0) break;
                    conv_one(a, lds + 65536, item, tid, wid, lane);
                }
                __syncthreads();
            }
        }
        SEAM(7);
        if (IN(8)) {
            const pg8::Gemm g{(const bf16_t*)(a.ws + WS_ACT), (const bf16_t*)(a.ws + WS_WD8), FF / 2};
            const int nu = build_moe_list(tb + 80, tb, cn, 8, G, vcu, RF(8), tid);
            const SchedList S{tb + 80, nu}; const EpiDown E{a.ws + WS_Y2, a.in[14], (const int*)(a.ws + WS_LIST), (const float*)(a.ws + WS_GATE), cn};
            pg8::gemm_phase<true, EpiDown, SchedList, true>(ldsl, g, S, E);
            __syncthreads();
        }
    }
    f32x4 pg9[8], pb9[8];
    if (IN(9)) {
#pragma unroll
        for (int i = 0; i < 8; ++i) { pg9[i] = *(const f32x4*)(a.in[15] + 4 * lane + 256 * i); pb9[i] = *(const f32x4*)(a.in[16] + 4 * lane + 256 * i); }
    }
    SEAM(8);
    if (IN(9)) { for (int rp = 0; rp < RF(9); ++rp) phase_final(a, wid, lane, pg9, pb9); }
#undef IN
#undef SEAM
}

extern "C" void kernel_launch(void* const* d_in, const int* in_sizes, int n_in, void* d_out, int out_size, void* d_ws, size_t ws_size, hipStream_t stream) {
    static int grid = 0;
    if (grid == 0) {
        int dev = 0, cus = 0;
        if (n_in != 17 || ws_size < WS_END) { fprintf(stderr, "kernel_launch: unexpected n_in %d / ws %zu\n", n_in, ws_size); grid = -1; return; }
        if (hipGetDevice(&dev) != hipSuccess || hipDeviceGetAttribute(&cus, hipDeviceAttributeMultiprocessorCount, dev) != hipSuccess) { grid = -1; return; }
        if (hipFuncSetAttribute((const void*)fwd_kernel, hipFuncAttributeMaxDynamicSharedMemorySize, LDS_BYTES) != hipSuccess) { fprintf(stderr, "kernel_launch: hipFuncSetAttribute failed\n"); grid = -1; return; }
        int per_cu = 0;
        (void)hipOccupancyMaxActiveBlocksPerMultiprocessor(&per_cu, (const void*)fwd_kernel, 512, LDS_BYTES);
        (void)hipGetLastError();
        grid = cus;
    }
    if (grid < 0) return;
    (void)hipMemsetAsync((char*)d_ws + WS_CTL, 0, CTL_ZERO_BYTES, stream);
    Args a{};
    for (int i = 0; i < 17; ++i) a.in[i] = (const float*)d_in[i];
    a.out = (float*)d_out; a.ws = (unsigned char*)d_ws;
    if (N_LAUNCH == 1) {
        a.ph_lo = 0; a.ph_hi = NPHASE;
        hipLaunchKernelGGL(fwd_kernel, dim3(grid), dim3(512), LDS_BYTES, stream, a);
    } else {
        for (int p = 0; p < NPHASE; ++p) { a.ph_lo = p; a.ph_hi = p + 1; hipLaunchKernelGGL(fwd_kernel, dim3(grid), dim3(512), LDS_BYTES, stream, a); }
    }
}
```
